# Optimizing an MI355X kernel written in HIP

```python
import math
import jax, jax.numpy as jnp
from jax import lax
import numpy as np


D_MODEL = 1024
BATCH = 4
SEQ = 4096
DEPTH = 2

RMS_EPS = 1e-6
D_FF = 2816
MACARON_WEIGHT = 0.5
N_EVEN = (DEPTH + 1) // 2
N_ODD = DEPTH // 2

POOL_WIDTH = D_MODEL // 2
POOL_GROUPS = 4
POOL_GROUP_DIM = POOL_WIDTH // POOL_GROUPS
POOL_WINDOWS = (2, 4, 8, 16)

HYENA_WIDTH = D_MODEL // 2
HYENA_ORDER = 2
HYENA_SHORT_CONV = 3
HYENA_POS_DIM = 33
HYENA_FILTER_HIDDEN = 64
HYENA_FAST_DECAY_PCT = 0.3
HYENA_SLOW_DECAY_PCT = 1.5
HYENA_DECAY_TARGET = 1e-2

EVEN_IN_WIDTH = POOL_WIDTH + (HYENA_ORDER + 1) * HYENA_WIDTH
EVEN_OUT_WIDTH = POOL_WIDTH + HYENA_WIDTH

MLA_HEADS = 16
MLA_Q_LORA = 256
MLA_KV_LORA = 128
MLA_NOPE = 64
MLA_ROPE = 32
MLA_V = 64
ROPE_THETA = 10000.0
Q_BLOCK = 128

kernel_name = "hybrid_pool_hyena_mla_macaron_encoder"


def rmsnorm(x, g):
    x32 = x.astype(jnp.float32)
    y = x32 * lax.rsqrt(jnp.mean(x32 * x32, axis=-1, keepdims=True) + RMS_EPS)
    return (y * g.astype(jnp.float32)).astype(x.dtype)


def swiglu(h, w_gate, w_up, w_down):
    return (jax.nn.silu(h @ w_gate) * (h @ w_up)) @ w_down


def centred_pool_minus_self(a):
    L = a.shape[1]
    a32 = a.astype(jnp.float32)
    csum = jnp.pad(jnp.cumsum(a32, axis=1), ((0, 0), (1, 0), (0, 0)))
    t = jnp.arange(L)
    outs = []
    for g, w in enumerate(POOL_WINDOWS):
        cg = csum[..., g * POOL_GROUP_DIM:(g + 1) * POOL_GROUP_DIM]
        lo = jnp.clip(t - w // 2, 0, L)
        hi = jnp.clip(t - w // 2 + w, 0, L)
        cnt = (hi - lo).astype(jnp.float32)[None, :, None]
        outs.append((jnp.take(cg, hi, axis=1) - jnp.take(cg, lo, axis=1)) / cnt)
    return (jnp.concatenate(outs, axis=-1) - a32).astype(a.dtype)


def pool_mixer(a, pool_w, pool_scale):
    B, L, _ = a.shape
    p = centred_pool_minus_self(a).reshape(B, L, POOL_GROUPS, POOL_GROUP_DIM)
    y = jnp.einsum('blgc,gcd->blgd', p, pool_w).reshape(B, L, POOL_WIDTH)
    return y * pool_scale


def short_conv_centred(u, w, b):
    L = u.shape[1]
    pad = HYENA_SHORT_CONV // 2
    up = jnp.pad(u, ((0, 0), (pad, HYENA_SHORT_CONV - 1 - pad), (0, 0)))
    y = b
    for k in range(HYENA_SHORT_CONV):
        y = y + up[:, k:k + L] * w[k]
    return y


def hyena_position_features(L):
    f32 = jnp.float32
    t = jnp.linspace(0.0, 1.0, L, dtype=f32)
    bands = (HYENA_POS_DIM - 1) // 2
    w = 2.0 * math.pi * jnp.arange(L, dtype=f32) / L
    f = jnp.linspace(1e-4, bands - 1, bands, dtype=f32)
    phase = w[:, None] * f[None, :]
    z = jnp.concatenate([t[:, None], jnp.cos(phase), -jnp.sin(phase)], axis=-1)
    return t, z


def hyena_filter_spectra(t, z, w1, b1, w2, b2, w3, b3, sin_freq, w_out, decay):
    f32 = jnp.float32
    L = t.shape[0]
    h = jnp.sin(sin_freq[0].astype(f32) * (z @ w1.astype(f32) + b1.astype(f32)))
    h = jnp.sin(sin_freq[1].astype(f32) * (h @ w2.astype(f32) + b2.astype(f32)))
    h = jnp.sin(sin_freq[2].astype(f32) * (h @ w3.astype(f32) + b3.astype(f32)))
    h = (h @ w_out.astype(f32)).reshape(L, HYENA_ORDER, 2, HYENA_WIDTH)
    h = h * jnp.exp(-t[:, None, None, None] * jnp.abs(decay.astype(f32)))
    fwd, bwd = h[:, :, 0], h[:, :, 1]
    two = jnp.concatenate(
        [fwd, jnp.zeros((1, HYENA_ORDER, HYENA_WIDTH), f32), bwd[:0:-1]], axis=0)
    two = two * lax.rsqrt(jnp.sum(two * two, axis=0, keepdims=True))
    return jnp.fft.rfft(two, axis=0)


def fft_long_conv(u, spec, bias):
    L = u.shape[1]
    u32 = u.astype(jnp.float32)
    y = jnp.fft.irfft(jnp.fft.rfft(u32, n=2 * L, axis=1) * spec[None], n=2 * L, axis=1)[:, :L]
    return (y + u32 * bias.astype(jnp.float32)).astype(u.dtype)


def hyena_mixer(u, conv_w, conv_b, spec, bias):
    u = short_conv_centred(u, conv_w, conv_b)
    parts = jnp.split(u, HYENA_ORDER + 1, axis=-1)
    z = parts[-1]
    for o in range(HYENA_ORDER):
        z = parts[o] * fft_long_conv(z, spec[:, o], bias[o])
    return z


def apply_rope(x, cos, sin):
    half = x.shape[-1] // 2
    x1, x2 = x[..., :half], x[..., half:]
    return jnp.concatenate([x1 * cos - x2 * sin, x1 * sin + x2 * cos], axis=-1)


def mla_mixer(h, w_dq, q_norm_g, w_uq, w_dkv, kv_norm_g, w_ukv, w_o, cos, sin):
    B, L, _ = h.shape
    cq = rmsnorm(h @ w_dq, q_norm_g)
    q = (cq @ w_uq).reshape(B, L, MLA_HEADS, MLA_NOPE + MLA_ROPE)
    q_nope, q_rope = q[..., :MLA_NOPE], q[..., MLA_NOPE:]
    q_rope = apply_rope(q_rope, cos[None, :, None, :], sin[None, :, None, :])
    ckv_full = h @ w_dkv
    ckv = rmsnorm(ckv_full[..., :MLA_KV_LORA], kv_norm_g)
    k_rope = apply_rope(ckv_full[..., MLA_KV_LORA:], cos[None], sin[None])
    kv = (ckv @ w_ukv).reshape(B, L, MLA_HEADS, MLA_NOPE + MLA_V)
    k_nope, v = kv[..., :MLA_NOPE], kv[..., MLA_NOPE:]
    scale = (MLA_NOPE + MLA_ROPE) ** -0.5
    nb = L // Q_BLOCK

    def to_blocks(a):
        return jnp.moveaxis(a.reshape(B, nb, Q_BLOCK, *a.shape[2:]), 1, 0)

    def attend(qs):
        qn, qr = qs
        s = (jnp.einsum('bqhd,bkhd->bhqk', qn, k_nope)
             + jnp.einsum('bqhr,bkr->bhqk', qr, k_rope))
        p = jax.nn.softmax(s.astype(jnp.float32) * scale, axis=-1).astype(v.dtype)
        return jnp.einsum('bhqk,bkhd->bqhd', p, v)

    o = lax.map(attend, (to_blocks(q_nope), to_blocks(q_rope)))
    o = jnp.moveaxis(o, 0, 1).reshape(B, L, MLA_HEADS * MLA_V)
    return o @ w_o


def setup_inputs(seed: int = 0) -> dict:
    key = jax.random.key(seed)
    ks = iter(jax.random.split(key, 32))

    def nrm(shape, scale):
        return jax.random.normal(next(ks), shape, jnp.float32) * scale

    D, F, W, FH = D_MODEL, D_FF, HYENA_WIDTH, HYENA_FILTER_HIDDEN
    decay_base = jnp.linspace(-math.log(HYENA_DECAY_TARGET) / HYENA_SLOW_DECAY_PCT,
                              -math.log(HYENA_DECAY_TARGET) / HYENA_FAST_DECAY_PCT, W,
                              dtype=jnp.float32)
    inp = {}
    inp["x"] = nrm((BATCH, SEQ, D), 1.0)
    inp["norm_g"] = 1.0 + nrm((DEPTH, 3, D), 0.05)
    inp["ffn_w_gate"] = nrm((DEPTH, 2, D, F), D ** -0.5)
    inp["ffn_w_up"] = nrm((DEPTH, 2, D, F), D ** -0.5)
    inp["ffn_w_down"] = nrm((DEPTH, 2, F, D), F ** -0.5)
    inp["mix_w_in"] = nrm((N_EVEN, D, EVEN_IN_WIDTH), D ** -0.5)
    inp["pool_w"] = nrm((N_EVEN, POOL_GROUPS, POOL_GROUP_DIM, POOL_GROUP_DIM), POOL_GROUP_DIM ** -0.5)
    inp["pool_scale"] = 1.0 + nrm((N_EVEN, POOL_WIDTH), 0.05)
    inp["hyena_conv_w"] = nrm((N_EVEN, HYENA_SHORT_CONV, (HYENA_ORDER + 1) * W), HYENA_SHORT_CONV ** -0.5)
    inp["hyena_conv_b"] = nrm((N_EVEN, (HYENA_ORDER + 1) * W), 0.02)
    inp["hyena_ffn_w1"] = nrm((N_EVEN, HYENA_POS_DIM, FH), HYENA_POS_DIM ** -0.5)
    inp["hyena_ffn_b1"] = nrm((N_EVEN, FH), 0.02)
    inp["hyena_ffn_w2"] = nrm((N_EVEN, FH, FH), FH ** -0.5)
    inp["hyena_ffn_b2"] = nrm((N_EVEN, FH), 0.02)
    inp["hyena_ffn_w3"] = nrm((N_EVEN, FH, FH), FH ** -0.5)
    inp["hyena_ffn_b3"] = nrm((N_EVEN, FH), 0.02)
    inp["hyena_sin_freq"] = 1.0 + nrm((N_EVEN, 3, FH), 0.1)
    inp["hyena_ffn_w_out"] = nrm((N_EVEN, FH, HYENA_ORDER * 2 * W), FH ** -0.5)
    inp["hyena_decay"] = decay_base * jnp.exp(nrm((N_EVEN, HYENA_ORDER, 2, W), 0.1))
    inp["hyena_bias"] = nrm((N_EVEN, HYENA_ORDER, W), 0.5)
    inp["mix_w_out"] = nrm((N_EVEN, EVEN_OUT_WIDTH, D), EVEN_OUT_WIDTH ** -0.5)
    inp["mla_w_dq"] = nrm((N_ODD, D, MLA_Q_LORA), D ** -0.5)
    inp["mla_q_norm_g"] = 1.0 + nrm((N_ODD, MLA_Q_LORA), 0.05)
    inp["mla_w_uq"] = nrm((N_ODD, MLA_Q_LORA, MLA_HEADS * (MLA_NOPE + MLA_ROPE)), MLA_Q_LORA ** -0.5)
    inp["mla_w_dkv"] = nrm((N_ODD, D, MLA_KV_LORA + MLA_ROPE), D ** -0.5)
    inp["mla_kv_norm_g"] = 1.0 + nrm((N_ODD, MLA_KV_LORA), 0.05)
    inp["mla_w_ukv"] = nrm((N_ODD, MLA_KV_LORA, MLA_HEADS * (MLA_NOPE + MLA_V)), MLA_KV_LORA ** -0.5)
    inp["mla_w_o"] = nrm((N_ODD, MLA_HEADS * MLA_V, D), (MLA_HEADS * MLA_V) ** -0.5)
    inp["final_norm_g"] = 1.0 + nrm((D,), 0.05)
    return inp


def reference(x, norm_g, ffn_w_gate, ffn_w_up, ffn_w_down, mix_w_in, pool_w, pool_scale,
              hyena_conv_w, hyena_conv_b, hyena_ffn_w1, hyena_ffn_b1, hyena_ffn_w2, hyena_ffn_b2,
              hyena_ffn_w3, hyena_ffn_b3, hyena_sin_freq, hyena_ffn_w_out, hyena_decay, hyena_bias,
              mix_w_out, mla_w_dq, mla_q_norm_g, mla_w_uq, mla_w_dkv, mla_kv_norm_g, mla_w_ukv,
              mla_w_o, final_norm_g):
    L = x.shape[1]
    t_pos, z_pos = hyena_position_features(L)
    inv_freq = ROPE_THETA ** (-jnp.arange(0, MLA_ROPE, 2, dtype=jnp.float32) / MLA_ROPE)
    ang = jnp.arange(L, dtype=jnp.float32)[:, None] * inv_freq[None, :]
    cos = jnp.cos(ang).astype(x.dtype)
    sin = jnp.sin(ang).astype(x.dtype)

    for i in range(DEPTH):
        x = x + MACARON_WEIGHT * swiglu(rmsnorm(x, norm_g[i, 0]),
                                        ffn_w_gate[i, 0], ffn_w_up[i, 0], ffn_w_down[i, 0])
        h = rmsnorm(x, norm_g[i, 1])
        j = i // 2
        if i % 2 == 0:
            proj = h @ mix_w_in[j]
            y_pool = pool_mixer(proj[..., :POOL_WIDTH], pool_w[j], pool_scale[j])
            spec = hyena_filter_spectra(t_pos, z_pos, hyena_ffn_w1[j], hyena_ffn_b1[j],
                                        hyena_ffn_w2[j], hyena_ffn_b2[j], hyena_ffn_w3[j],
                                        hyena_ffn_b3[j], hyena_sin_freq[j], hyena_ffn_w_out[j],
                                        hyena_decay[j])
            y_hyena = hyena_mixer(proj[..., POOL_WIDTH:], hyena_conv_w[j], hyena_conv_b[j],
                                  spec, hyena_bias[j])
            x = x + jnp.concatenate([y_pool, y_hyena], axis=-1) @ mix_w_out[j]
        else:
            x = x + mla_mixer(h, mla_w_dq[j], mla_q_norm_g[j], mla_w_uq[j], mla_w_dkv[j],
                              mla_kv_norm_g[j], mla_w_ukv[j], mla_w_o[j], cos, sin)
        x = x + MACARON_WEIGHT * swiglu(rmsnorm(x, norm_g[i, 2]),
                                        ffn_w_gate[i, 1], ffn_w_up[i, 1], ffn_w_down[i, 1])
    return rmsnorm(x, final_norm_g)
```

```cpp
#include <hip/hip_runtime.h>
#include <hip/hip_cooperative_groups.h>
#include <cstdio>
#include <cstdint>
namespace cg = cooperative_groups;

#define LAS __attribute__((address_space(3)))
typedef unsigned short bf16_t;
typedef short bf16x8 __attribute__((ext_vector_type(8)));
typedef short s16x4 __attribute__((ext_vector_type(4)));
typedef float f32x4 __attribute__((ext_vector_type(4)));
typedef float f32x16 __attribute__((ext_vector_type(16)));
typedef unsigned u32x4 __attribute__((ext_vector_type(4)));
typedef unsigned u32x2 __attribute__((ext_vector_type(2)));

__device__ __forceinline__ unsigned cvt_pk_bf16(float lo, float hi) { unsigned r; asm volatile("v_cvt_pk_bf16_f32 %0, %1, %2" : "=v"(r) : "v"(lo), "v"(hi)); return r; }
__device__ __forceinline__ unsigned f2bf(float f) { unsigned u = __builtin_bit_cast(unsigned, f); return (u + 0x7fffu + ((u >> 16) & 1u)) >> 16; }
__device__ __forceinline__ float bf2f(bf16_t b) { return __builtin_bit_cast(float, (unsigned)b << 16); }
__device__ __forceinline__ int tid_opaque(int wv) { int l = __builtin_amdgcn_mbcnt_hi(~0u, __builtin_amdgcn_mbcnt_lo(~0u, 0u)); asm volatile("" : "+v"(l)); return (wv << 6) | l; }
__device__ __forceinline__ float wave_sum(float v) {
    int l = __builtin_amdgcn_mbcnt_hi(~0u, __builtin_amdgcn_mbcnt_lo(~0u, 0u)); asm volatile("" : "+v"(l));
#pragma unroll
    for (int o = 1; o < 64; o <<= 1) v += __builtin_bit_cast(float, __builtin_amdgcn_ds_bpermute((l ^ o) << 2, __builtin_bit_cast(int, v)));
    return v;
}

namespace pg8 {
constexpr int BM = 256, BK = 64, HALF = 128, HTB = HALF * BK * 2, STAGE_BYTES = 8 * HTB, NXCD = 8, WGM = 8;
__host__ __device__ __forceinline__ int lds_byte(int r, int c) { const int st = (r >> 4) * 2 + (c >> 5), rr = r & 15, cc = c & 31, ob = rr * 64 + cc * 2; return st * 1024 + (ob ^ (((ob >> 9) & 1) << 5)); }
__host__ __device__ __forceinline__ void stage_rc(int b, int& R, int& C) { const int st = b / 1024, sb = b % 1024, swz = sb ^ (((sb >> 9) & 1) << 5); R = (st >> 1) * 16 + swz / 64; C = (st & 1) * 32 + (swz % 64) / 2; }
__host__ __device__ __forceinline__ int perm32(int rho) { const int n = rho >> 4, i = rho & 15; return 8 * (i >> 2) + 4 * n + (i & 3); }
struct Unit { int pm, pn; };
struct Gemm { const bf16_t* A; const bf16_t* Bt; int M, N, K, ld; };
struct StaticOrder {
    int nM, nN, nwg, G, c;
    __host__ __device__ void init(int M, int N, int G_, int c_) { nM = M / BM; nN = N / BM; nwg = nM * nN; G = G_; c = c_; }
    __host__ __device__ bool next(int i, Unit& u) const {
        const long L = (long)i * G + c; if (L >= nwg) return false;
        int wgid = (int)L; { const int q = nwg / NXCD, r = nwg % NXCD, xcd = wgid % NXCD, off = wgid / NXCD; wgid = (xcd < r ? xcd * (q + 1) : r * (q + 1) + (xcd - r) * q) + off; }
        const int nig = WGM * nN, gid = wgid / nig, fm = gid * WGM, gsz = (nM - fm) < WGM ? (nM - fm) : WGM;
        u.pm = fm + ((wgid % nig) % gsz); u.pn = (wgid % nig) / gsz; return true;
    }
    __device__ __forceinline__ void a_ready(const Unit&) const {}
    __device__ __forceinline__ void done(const Unit&) const {}
};

template <class Epi, class Sched, bool ALIGN_EPI = false, bool SP2 = false>
__device__ __forceinline__ void gemm_phase(LAS unsigned char* lds, const Gemm g, const Sched& S, const Epi& E, int wv) {
    const int tid = tid_opaque(wv), wid = __builtin_amdgcn_readfirstlane(tid >> 6), lane = tid & 63, wr = wid >> 2, wc = wid & 3, fr = lane & 15, fq = lane >> 4;
    const int K = g.ld, nt = g.K / BK;
    unsigned voffA[2], voffB[2];
#pragma unroll
    for (int i = 0; i < 2; ++i) { int R, C; stage_rc(tid * 16 + i * 8192, R, C); const int Rb = Epi::PERM ? ((R & ~31) + perm32(R & 31)) : R;
        voffA[i] = (unsigned)(R * K + C) * 2u; voffB[i] = (unsigned)(Rb * K + C) * 2u; }
    const size_t kstep = (size_t)(BK * 2);
    const size_t hstep = (size_t)HALF * K * 2;
    const size_t tstep = 2 * hstep;
    const unsigned ldsw = (unsigned)wid * 1024u;
    const int aoff = lds_byte(wr * 64 + fr, fq * 8), boff = lds_byte(wc * 32 + fr, fq * 8);
#define PG8_SA(b, h) (((b) * 2 + (h)) * HTB)
#define PG8_SB(b, h) ((4 + (b) * 2 + (h)) * HTB)
#define PG8_STAGE(bufoff, gbase, voff) do { _Pragma("unroll") for (int _i = 0; _i < 2; ++_i) \
        __builtin_amdgcn_global_load_lds((const unsigned*)((const char*)(gbase) + (voff)[_i]), (LAS unsigned*)(lds + (bufoff) + ldsw + _i * 8192), 16, 0, 0); } while (0)
#define PG8_LDA(dst, b, h) do { _Pragma("unroll") for (int m = 0; m < 4; ++m) _Pragma("unroll") for (int k = 0; k < 2; ++k) dst[m][k] = *(const LAS bf16x8*)(lds + PG8_SA(b, h) + aoff + m * 2048 + k * 1024); } while (0)
#define PG8_LDB(dst, b, h) do { _Pragma("unroll") for (int n = 0; n < 2; ++n) _Pragma("unroll") for (int k = 0; k < 2; ++k) dst[n][k] = *(const LAS bf16x8*)(lds + PG8_SB(b, h) + boff + n * 2048 + k * 1024); } while (0)
#define PG8_MMA(ai, bj, At, Bt) do { __builtin_amdgcn_s_setprio(1); _Pragma("unroll") for (int m = 0; m < 4; ++m) _Pragma("unroll") for (int n = 0; n < 2; ++n) _Pragma("unroll") for (int k = 0; k < 2; ++k) \
        acc[ai][bj][m][n] = __builtin_amdgcn_mfma_f32_16x16x32_bf16(Bt[n][k], At[m][k], acc[ai][bj][m][n], 0, 0, 0); __builtin_amdgcn_s_setprio(0); } while (0)
#define PG8_WAIT_V(n) asm volatile("s_waitcnt vmcnt(" #n ")" ::: "memory")
#define PG8_WAIT_L(n) asm volatile("s_waitcnt lgkmcnt(" #n ")" ::: "memory")
#define PG8_BAR __builtin_amdgcn_s_barrier()
#define PG8_SCHED __builtin_amdgcn_sched_barrier(0)
    Unit cur, nxt; int ui = 0;
    if (!S.next(0, cur)) return;
    f32x4 acc[2][2][4][2];
#pragma unroll
    for (int a = 0; a < 2; ++a)
#pragma unroll
        for (int b = 0; b < 2; ++b)
#pragma unroll
            for (int m = 0; m < 4; ++m)
#pragma unroll
                for (int n = 0; n < 2; ++n) acc[a][b][m][n] = (f32x4){0.f, 0.f, 0.f, 0.f};
    bf16x8 At[4][2], B0[2][2], B1[2][2];
    const char* cA = (const char*)g.A + (size_t)cur.pm * tstep; const char* cB = (const char*)g.Bt + (size_t)cur.pn * tstep;
    S.a_ready(cur);
    if constexpr (SP2) {
        PG8_STAGE(PG8_SB(0, 0), cB, voffB); PG8_STAGE(PG8_SB(0, 1), cB + hstep, voffB); PG8_STAGE(PG8_SA(0, 0), cA, voffA); PG8_STAGE(PG8_SA(0, 1), cA + hstep, voffA);
        if (wr == 1) PG8_BAR;
        PG8_WAIT_V(2); PG8_BAR;
        PG8_STAGE(PG8_SB(1, 0), cB + kstep, voffB); PG8_STAGE(PG8_SA(1, 0), cA + kstep, voffA); PG8_STAGE(PG8_SB(1, 1), cB + hstep + kstep, voffB);
        PG8_WAIT_V(6); PG8_BAR;
    } else {
        PG8_STAGE(PG8_SB(0, 0), cB, voffB); PG8_STAGE(PG8_SA(0, 0), cA, voffA); PG8_STAGE(PG8_SB(0, 1), cB + hstep, voffB); PG8_STAGE(PG8_SA(0, 1), cA + hstep, voffA);
        if (wr == 1) PG8_BAR;
        PG8_WAIT_V(4); PG8_BAR;
        PG8_STAGE(PG8_SB(1, 0), cB + kstep, voffB); PG8_STAGE(PG8_SA(1, 0), cA + kstep, voffA); PG8_STAGE(PG8_SB(1, 1), cB + hstep + kstep, voffB);
        PG8_WAIT_V(6); PG8_BAR;
    }
    for (;;) {
        const bool has_next = S.next(ui + 1, nxt);
        const char* nA = has_next ? (const char*)g.A + (size_t)nxt.pm * tstep : cA; const char* nB = has_next ? (const char*)g.Bt + (size_t)nxt.pn * tstep : cB;
        for (int t = 0; t < nt; t += 2) {
            const bool last = (t == nt - 2);
            const char* a1 = cA + (size_t)(t + 1) * kstep;
            const char* a2 = last ? nA : cA + (size_t)(t + 2) * kstep; const char* b2 = last ? nB : cB + (size_t)(t + 2) * kstep;
            const char* a3 = a2 + kstep; const char* b3 = b2 + kstep;
            if (last && has_next) S.a_ready(nxt);
            if constexpr (SP2) {
            PG8_LDB(B0, 0, 0); PG8_LDB(B1, 0, 1); PG8_SCHED; PG8_LDA(At, 0, 0); PG8_STAGE(PG8_SA(1, 1), a1 + hstep, voffA);
            PG8_WAIT_V(8); PG8_WAIT_L(0); PG8_BAR; PG8_MMA(0, 0, At, B0); PG8_MMA(0, 1, At, B1); PG8_BAR; PG8_SCHED;
            PG8_LDA(At, 0, 1); PG8_STAGE(PG8_SB(0, 0), b2, voffB); PG8_STAGE(PG8_SB(0, 1), b2 + hstep, voffB); PG8_STAGE(PG8_SA(0, 0), a2, voffA);
            PG8_WAIT_V(8); PG8_WAIT_L(0); PG8_BAR; PG8_MMA(1, 0, At, B0); PG8_MMA(1, 1, At, B1); PG8_BAR; PG8_SCHED;
            PG8_LDB(B0, 1, 0); PG8_LDB(B1, 1, 1); PG8_SCHED; PG8_LDA(At, 1, 0); PG8_STAGE(PG8_SA(0, 1), a2 + hstep, voffA);
            PG8_WAIT_V(8); PG8_WAIT_L(0); PG8_BAR; PG8_MMA(0, 0, At, B0); PG8_MMA(0, 1, At, B1); PG8_BAR; PG8_SCHED;
            PG8_LDA(At, 1, 1); PG8_STAGE(PG8_SB(1, 0), b3, voffB); PG8_STAGE(PG8_SB(1, 1), b3 + hstep, voffB); PG8_STAGE(PG8_SA(1, 0), a3, voffA);
            PG8_WAIT_V(8); PG8_WAIT_L(0); PG8_BAR; PG8_MMA(1, 0, At, B0); PG8_MMA(1, 1, At, B1); PG8_BAR; PG8_SCHED;
            } else {
            PG8_LDB(B0, 0, 0); PG8_SCHED; PG8_LDA(At, 0, 0); PG8_STAGE(PG8_SA(1, 1), a1 + hstep, voffA);
            PG8_WAIT_L(8); PG8_BAR; PG8_WAIT_L(0); PG8_MMA(0, 0, At, B0); PG8_BAR; PG8_SCHED;
            PG8_LDB(B1, 0, 1); PG8_STAGE(PG8_SB(0, 0), b2, voffB);
            PG8_BAR; PG8_WAIT_L(0); PG8_MMA(0, 1, At, B1); PG8_BAR;
            PG8_LDA(At, 0, 1); PG8_STAGE(PG8_SA(0, 0), a2, voffA);
            PG8_BAR; PG8_WAIT_L(0); PG8_MMA(1, 0, At, B0); PG8_BAR; PG8_SCHED;
            PG8_STAGE(PG8_SB(0, 1), b2 + hstep, voffB);
            PG8_WAIT_V(6); PG8_BAR; PG8_MMA(1, 1, At, B1); PG8_BAR;
            PG8_LDB(B0, 1, 0); PG8_SCHED; PG8_LDA(At, 1, 0); PG8_STAGE(PG8_SA(0, 1), a2 + hstep, voffA);
            PG8_WAIT_L(8); PG8_BAR; PG8_WAIT_L(0); PG8_MMA(0, 0, At, B0); PG8_BAR; PG8_SCHED;
            PG8_LDB(B1, 1, 1); PG8_STAGE(PG8_SB(1, 0), b3, voffB);
            PG8_BAR; PG8_WAIT_L(0); PG8_MMA(0, 1, At, B1); PG8_BAR;
            PG8_LDA(At, 1, 1); PG8_STAGE(PG8_SA(1, 0), a3, voffA);
            PG8_BAR; PG8_WAIT_L(0); PG8_MMA(1, 0, At, B0); PG8_BAR; PG8_SCHED;
            PG8_STAGE(PG8_SB(1, 1), b3 + hstep, voffB);
            PG8_WAIT_V(6); PG8_BAR; PG8_MMA(1, 1, At, B1); PG8_BAR;
            }
        }
        if constexpr (ALIGN_EPI) { if (wr == 0) PG8_BAR; }
        { int le = __builtin_amdgcn_mbcnt_hi(~0u, __builtin_amdgcn_mbcnt_lo(~0u, 0u)); asm volatile("" : "+v"(le));
          E(acc, cur, wr, wc, le & 15, le >> 4); } S.done(cur);
        if (!has_next) break;
#pragma unroll
        for (int a = 0; a < 2; ++a)
#pragma unroll
            for (int b = 0; b < 2; ++b)
#pragma unroll
                for (int m = 0; m < 4; ++m)
#pragma unroll
                    for (int n = 0; n < 2; ++n) acc[a][b][m][n] = (f32x4){0.f, 0.f, 0.f, 0.f};
        cur = nxt; cA = nA; cB = nB; ++ui;
        if constexpr (ALIGN_EPI) { if (wr == 1) PG8_BAR; }
    }
    PG8_WAIT_V(0);
    if constexpr (!ALIGN_EPI) { if (wr == 0) PG8_BAR; }
    PG8_BAR;
#undef PG8_SA
#undef PG8_SB
#undef PG8_STAGE
#undef PG8_LDA
#undef PG8_LDB
#undef PG8_MMA
#undef PG8_WAIT_V
#undef PG8_WAIT_L
#undef PG8_BAR
#undef PG8_SCHED
}
}

constexpr int NB = 4, SEQ = 4096, DM = 1024, FF = 2816, MTOK = NB * SEQ;
constexpr float EPS = 1e-6f;
constexpr size_t MiB = 1u << 20;
constexpr size_t WS_SSQ = 0;
constexpr size_t WS_SSQQ = 512 * 1024;
constexpr size_t WS_SSQKV = 576 * 1024;
constexpr size_t WS_CNT = 640 * 1024;
constexpr size_t WS_BAR = 768 * 1024;
constexpr size_t WS_HID3 = 1 * MiB;
constexpr size_t WS_KR = 3 * MiB;
constexpr size_t WS_Z1 = 4 * MiB;
constexpr size_t WS_WGU = 20 * MiB;
constexpr size_t WS_WD = 64 * MiB;
constexpr size_t WS_WIN = 86 * MiB;
constexpr size_t WS_WPOOL = 90 * MiB;
constexpr size_t WS_WOUT = 91 * MiB;
constexpr size_t WS_WD1 = 93 * MiB;
constexpr size_t WS_WUP = 94 * MiB;
constexpr size_t WS_WO = 97 * MiB;
constexpr size_t WS_XB = 100 * MiB;
constexpr size_t WS_BIG = 132 * MiB;
constexpr size_t WS_ACT = WS_BIG;
constexpr size_t WS_APOOL = WS_BIG;
constexpr size_t WS_UC = WS_BIG + 16 * MiB;
constexpr size_t WS_PP = WS_BIG + 64 * MiB;
constexpr size_t WS_YC = WS_BIG + 80 * MiB;
constexpr size_t WS_Y = WS_BIG;
constexpr size_t WS_A2 = WS_BIG;
constexpr size_t WS_Q = WS_BIG + 12 * MiB;
constexpr size_t WS_KV = WS_BIG + 60 * MiB;
constexpr size_t WS_O = 20 * MiB;
constexpr size_t WS_END = 256 * MiB;
static_assert(WS_KV + (size_t)MTOK * 2048 * 2 <= WS_END && WS_YC + 16 * MiB <= WS_END && WS_ACT + (size_t)MTOK * FF * 2 <= WS_END, "ws map");
static_assert(WS_SSQKV == WS_SSQQ + (size_t)MTOK * 4, "ssq_kv follows ssq_q");
constexpr int LDS_BYTES = 147456;
constexpr int FFT_BUF = 8704 * 8;

using pg8::Unit;
typedef f32x4 AccT[2][2][4][2];
__device__ __forceinline__ float silu_mul(float g, float u) { return g * __builtin_amdgcn_rcpf(1.f + __expf(-g)) * u; }

struct EpiAct { static constexpr bool PERM = true;
    bf16_t* O; const float* ssq;
    __device__ __forceinline__ void operator()(const AccT& acc, const Unit& u, int wr, int wc, int fr, int fq) const {
        const int row0 = u.pm * 256 + wr * 64 + fr, col0 = u.pn * 128 + wc * 32 + 8 * fq;
        float rsv[8];
#pragma unroll
        for (int i = 0; i < 8; ++i) rsv[i] = ssq[row0 + (i >> 2) * 128 + (i & 3) * 16];
#pragma unroll
        for (int ai = 0; ai < 2; ++ai)
#pragma unroll
            for (int m = 0; m < 4; ++m) { const int row = row0 + ai * 128 + m * 16; const float rs = rsqrtf(rsv[ai * 4 + m] * (1.f / DM) + EPS);
                const float nrl = -1.4426950408889634f * rs, rs2 = rs * rs; f32x4 y[2];
#pragma unroll
                for (int n = 0; n < 2; ++n) { const f32x4 ag = acc[ai][0][m][n], au = acc[ai][1][m][n]; const f32x4 t = ag * nrl;
                    f32x4 d; d[0] = __builtin_amdgcn_exp2f(t[0]); d[1] = __builtin_amdgcn_exp2f(t[1]); d[2] = __builtin_amdgcn_exp2f(t[2]); d[3] = __builtin_amdgcn_exp2f(t[3]);
                    d = d + 1.0f; f32x4 r; r[0] = __builtin_amdgcn_rcpf(d[0]); r[1] = __builtin_amdgcn_rcpf(d[1]); r[2] = __builtin_amdgcn_rcpf(d[2]); r[3] = __builtin_amdgcn_rcpf(d[3]);
                    y[n] = ((ag * au) * rs2) * r; }
                u32x4 w; w.x = cvt_pk_bf16(y[0][0], y[0][1]); w.y = cvt_pk_bf16(y[0][2], y[0][3]); w.z = cvt_pk_bf16(y[1][0], y[1][1]); w.w = cvt_pk_bf16(y[1][2], y[1][3]);
                *(u32x4*)(O + (size_t)row * FF + col0) = w; }
    }
};
struct EpiRes { static constexpr bool PERM = true;
    const float* xin32; bf16_t* xb; float* ssq_next; float alpha;
    __device__ __forceinline__ void operator()(const AccT& acc, const Unit& u, int wr, int wc, int fr, int fq) const {
        const int row0 = u.pm * 256 + wr * 64 + fr, col0 = u.pn * 256 + wc * 32 + 8 * fq;
        u32x4 xr[8][2];
#pragma unroll
        for (int i = 0; i < 8; ++i)
#pragma unroll
            for (int bj = 0; bj < 2; ++bj) xr[i][bj] = *(const u32x4*)(xb + (size_t)(row0 + (i >> 2) * 128 + (i & 3) * 16) * DM + col0 + bj * 128);
#pragma unroll
        for (int ai = 0; ai < 2; ++ai)
#pragma unroll
            for (int m = 0; m < 4; ++m) { const int row = row0 + ai * 128 + m * 16; float sq = 0.f;
#pragma unroll
                for (int bj = 0; bj < 2; ++bj) { const size_t off = (size_t)row * DM + col0 + bj * 128; f32x4 x0, x1;
                    if (xin32) { x0 = *(const f32x4*)(xin32 + off); x1 = *(const f32x4*)(xin32 + off + 4); }
                    else { const u32x4 w = xr[ai * 4 + m][bj];
                        x0 = (f32x4){__builtin_bit_cast(float, w.x << 16), __builtin_bit_cast(float, w.x & 0xffff0000u), __builtin_bit_cast(float, w.y << 16), __builtin_bit_cast(float, w.y & 0xffff0000u)};
                        x1 = (f32x4){__builtin_bit_cast(float, w.z << 16), __builtin_bit_cast(float, w.z & 0xffff0000u), __builtin_bit_cast(float, w.w << 16), __builtin_bit_cast(float, w.w & 0xffff0000u)}; }
                    x0 = x0 + acc[ai][bj][m][0] * alpha; x1 = x1 + acc[ai][bj][m][1] * alpha;
                    sq += ((x0[0] * x0[0] + x0[1] * x0[1]) + (x0[2] * x0[2] + x0[3] * x0[3])) + ((x1[0] * x1[0] + x1[1] * x1[1]) + (x1[2] * x1[2] + x1[3] * x1[3]));
                    u32x4 o; o.x = cvt_pk_bf16(x0[0], x0[1]); o.y = cvt_pk_bf16(x0[2], x0[3]); o.z = cvt_pk_bf16(x1[0], x1[1]); o.w = cvt_pk_bf16(x1[2], x1[3]);
                    *(u32x4*)(xb + off) = o; }
                sq += __shfl_xor(sq, 16); sq += __shfl_xor(sq, 32);
                if (fq == 0) atomicAdd(ssq_next + row, sq); }
    }
};
struct EpiResFinal { static constexpr bool PERM = true;
    const bf16_t* xb; float* ssq; unsigned* cnt; const float* gfin; float* out; float alpha; int wv;
    __device__ __forceinline__ void operator()(AccT& acc, const Unit& u, int wr, int wc, int fr, int fq) const {
        const int row0 = u.pm * 256 + wr * 64 + fr, col0 = u.pn * 256 + wc * 32 + 8 * fq;
        u32x4 xr[8][2];
#pragma unroll
        for (int i = 0; i < 8; ++i)
#pragma unroll
            for (int bj = 0; bj < 2; ++bj) xr[i][bj] = *(const u32x4*)(xb + (size_t)(row0 + (i >> 2) * 128 + (i & 3) * 16) * DM + col0 + bj * 128);
#pragma unroll
        for (int ai = 0; ai < 2; ++ai)
#pragma unroll
            for (int m = 0; m < 4; ++m) { const int row = row0 + ai * 128 + m * 16; float sq = 0.f;
#pragma unroll
                for (int bj = 0; bj < 2; ++bj) { const u32x4 w = xr[ai * 4 + m][bj];
                    f32x4 x0 = (f32x4){__builtin_bit_cast(float, w.x << 16), __builtin_bit_cast(float, w.x & 0xffff0000u), __builtin_bit_cast(float, w.y << 16), __builtin_bit_cast(float, w.y & 0xffff0000u)};
                    f32x4 x1 = (f32x4){__builtin_bit_cast(float, w.z << 16), __builtin_bit_cast(float, w.z & 0xffff0000u), __builtin_bit_cast(float, w.w << 16), __builtin_bit_cast(float, w.w & 0xffff0000u)};
                    x0 = x0 + acc[ai][bj][m][0] * alpha; x1 = x1 + acc[ai][bj][m][1] * alpha; acc[ai][bj][m][0] = x0; acc[ai][bj][m][1] = x1;
                    sq += ((x0[0] * x0[0] + x0[1] * x0[1]) + (x0[2] * x0[2] + x0[3] * x0[3])) + ((x1[0] * x1[0] + x1[1] * x1[1]) + (x1[2] * x1[2] + x1[3] * x1[3])); }
                sq += __shfl_xor(sq, 16); sq += __shfl_xor(sq, 32);
                if (fq == 0) atomicAdd(ssq + row, sq); }
        asm volatile("s_waitcnt vmcnt(0) lgkmcnt(0)" ::: "memory"); __builtin_amdgcn_s_barrier(); asm volatile("" ::: "memory");
        if (wv == 0) {
            if ((fr | fq) == 0) { __threadfence(); __hip_atomic_fetch_add(cnt + u.pm, 1u, __ATOMIC_RELAXED, __HIP_MEMORY_SCOPE_AGENT); }
            unsigned spins = 0;
            while (__hip_atomic_load(cnt + u.pm, __ATOMIC_RELAXED, __HIP_MEMORY_SCOPE_AGENT) < 4u && ++spins < (1u << 22)) __builtin_amdgcn_s_sleep(2);
        }
        asm volatile("s_waitcnt vmcnt(0) lgkmcnt(0)" ::: "memory"); __builtin_amdgcn_s_barrier(); asm volatile("" ::: "memory");
        __builtin_amdgcn_fence(__ATOMIC_ACQUIRE, "agent");
        float tot[8]; f32x4 gv[2][2];
#pragma unroll
        for (int i = 0; i < 8; ++i) tot[i] = ssq[row0 + (i >> 2) * 128 + (i & 3) * 16];
#pragma unroll
        for (int bj = 0; bj < 2; ++bj) { gv[bj][0] = *(const f32x4*)(gfin + col0 + bj * 128); gv[bj][1] = *(const f32x4*)(gfin + col0 + bj * 128 + 4); }
#pragma unroll
        for (int ai = 0; ai < 2; ++ai)
#pragma unroll
            for (int m = 0; m < 4; ++m) { const int row = row0 + ai * 128 + m * 16; const float rs = rsqrtf(tot[ai * 4 + m] * (1.f / DM) + EPS);
#pragma unroll
                for (int bj = 0; bj < 2; ++bj) { const size_t off = (size_t)row * DM + col0 + bj * 128;
                    *(f32x4*)(out + off) = acc[ai][bj][m][0] * rs * gv[bj][0]; *(f32x4*)(out + off + 4) = acc[ai][bj][m][1] * rs * gv[bj][1]; } }
    }
};
struct EpiMixIn { static constexpr bool PERM = true;
    bf16_t* apool; bf16_t* uc; const float* ssq;
    __device__ __forceinline__ void operator()(const AccT& acc, const Unit& u, int wr, int wc, int fr, int fq) const {
        const int row0 = u.pm * 256 + wr * 64 + fr;
        float rsv[8];
#pragma unroll
        for (int i = 0; i < 8; ++i) rsv[i] = ssq[row0 + (i >> 2) * 128 + (i & 3) * 16];
#pragma unroll
        for (int ai = 0; ai < 2; ++ai)
#pragma unroll
            for (int m = 0; m < 4; ++m) { const int row = row0 + ai * 128 + m * 16; const float rs = rsqrtf(rsv[ai * 4 + m] * (1.f / DM) + EPS);
                if (u.pn < 2) {
#pragma unroll
                    for (int bj = 0; bj < 2; ++bj) { const f32x4 v0 = acc[ai][bj][m][0] * rs, v1 = acc[ai][bj][m][1] * rs;
                        u32x4 w; w.x = cvt_pk_bf16(v0[0], v0[1]); w.y = cvt_pk_bf16(v0[2], v0[3]); w.z = cvt_pk_bf16(v1[0], v1[1]); w.w = cvt_pk_bf16(v1[2], v1[3]);
                        *(u32x4*)(apool + (size_t)row * 512 + u.pn * 256 + bj * 128 + wc * 32 + 8 * fq) = w; }
                } else {
                    const int b = row >> 12, t = row & 4095;
#pragma unroll
                    for (int bj = 0; bj < 2; ++bj)
#pragma unroll
                        for (int n = 0; n < 2; ++n) { const f32x4 v = acc[ai][bj][m][n] * rs; const int ch = (u.pn - 2) * 256 + bj * 128 + wc * 32 + 8 * fq + 4 * n;
                            bf16_t* p = uc + (((size_t)(b * 1536 + ch)) << 12) + t;
                            p[0] = (bf16_t)f2bf(v[0]); p[4096] = (bf16_t)f2bf(v[1]); p[8192] = (bf16_t)f2bf(v[2]); p[12288] = (bf16_t)f2bf(v[3]); }
                } }
    }
};
struct EpiPlain { static constexpr bool PERM = true;
    bf16_t* O; int ldc;
    __device__ __forceinline__ void operator()(const AccT& acc, const Unit& u, int wr, int wc, int fr, int fq) const {
        const int row0 = u.pm * 256 + wr * 64 + fr, col0 = u.pn * 256 + wc * 32 + 8 * fq;
#pragma unroll
        for (int ai = 0; ai < 2; ++ai)
#pragma unroll
            for (int m = 0; m < 4; ++m) { const int row = row0 + ai * 128 + m * 16;
#pragma unroll
                for (int bj = 0; bj < 2; ++bj) { const f32x4 v0 = acc[ai][bj][m][0], v1 = acc[ai][bj][m][1];
                    u32x4 w; w.x = cvt_pk_bf16(v0[0], v0[1]); w.y = cvt_pk_bf16(v0[2], v0[3]); w.z = cvt_pk_bf16(v1[0], v1[1]); w.w = cvt_pk_bf16(v1[2], v1[3]);
                    *(u32x4*)(O + (size_t)row * ldc + col0 + bj * 128) = w; } }
    }
};
__device__ __forceinline__ void sincos_fast(float ang, float& s, float& c) {
    const float hi = 0.15915494f, lo = 6.4206383e-9f;
    const float r = ang * hi, e = fmaf(ang, hi, -r), k = rintf(r);
    const float frac = (r - k) + fmaf(ang, lo, e);
    s = __builtin_amdgcn_sinf(frac); c = __builtin_amdgcn_cosf(frac);
}
__device__ __forceinline__ float rope_inv_freq(int i) { return exp2f(-(float)(2 * i) * (13.287712379549449f / 32.f)); }
struct EpiM1 { static constexpr bool PERM = false;
    bf16_t* a2; bf16_t* kr; const float* ssq; float* ssq_q;
    __device__ __forceinline__ void operator()(const AccT& acc, const Unit& u, int wr, int wc, int fr, int fq) const {
        const int row0 = u.pm * 256 + wr * 64 + fr;
        float rsv[8];
#pragma unroll
        for (int i = 0; i < 8; ++i) rsv[i] = ssq[row0 + (i >> 2) * 128 + (i & 3) * 16];
#pragma unroll
        for (int ai = 0; ai < 2; ++ai)
#pragma unroll
            for (int m = 0; m < 4; ++m) { const int row = row0 + ai * 128 + m * 16; const float rs = rsqrtf(rsv[ai * 4 + m] * (1.f / DM) + EPS); float sq = 0.f;
                const int nbj = (u.pn == 0) ? 2 : 1;
#pragma unroll
                for (int bj = 0; bj < 2; ++bj) if (bj < nbj)
#pragma unroll
                    for (int n = 0; n < 2; ++n) { const f32x4 v = acc[ai][bj][m][n] * rs; sq += (v[0] * v[0] + v[1] * v[1]) + (v[2] * v[2] + v[3] * v[3]);
                        u32x2 w; w.x = cvt_pk_bf16(v[0], v[1]); w.y = cvt_pk_bf16(v[2], v[3]);
                        *(u32x2*)(a2 + (size_t)row * 384 + u.pn * 256 + bj * 128 + wc * 32 + n * 16 + 4 * fq) = w; }
                sq += __shfl_xor(sq, 16); sq += __shfl_xor(sq, 32);
                if (fq == 0) atomicAdd(ssq_q + (size_t)u.pn * MTOK + row, sq);
                if (u.pn == 1 && wc == 0) { const f32x4 x1 = acc[ai][1][m][0] * rs, x2 = acc[ai][1][m][1] * rs; const float pos = (float)(row & 4095);
                    float o1[4], o2[4];
#pragma unroll
                    for (int j = 0; j < 4; ++j) { const float ang = pos * rope_inv_freq(4 * fq + j); float c, s; sincos_fast(ang, s, c); o1[j] = x1[j] * c - x2[j] * s; o2[j] = x1[j] * s + x2[j] * c; }
                    u32x2 w1, w2; w1.x = cvt_pk_bf16(o1[0], o1[1]); w1.y = cvt_pk_bf16(o1[2], o1[3]); w2.x = cvt_pk_bf16(o2[0], o2[1]); w2.y = cvt_pk_bf16(o2[2], o2[3]);
                    *(u32x2*)(kr + (size_t)row * 32 + 4 * fq) = w1; *(u32x2*)(kr + (size_t)row * 32 + 16 + 4 * fq) = w2; }
                __builtin_amdgcn_sched_barrier(0); }
    }
};
struct EpiM2 { static constexpr bool PERM = false;
    bf16_t* q; bf16_t* kv; const float* ssq_q; const float* ssq_kv; int pn0;
    __device__ __forceinline__ void operator()(const AccT& acc, const Unit& u, int wr, int wc, int fr, int fq) const {
        asm volatile("" : "+v"(fr), "+v"(fq));
        const int upn = u.pn + pn0; const int row0 = u.pm * 256 + wr * 64 + fr; const bool isq = upn < 6;
        float rsv[8]; { const float* sp = isq ? ssq_q : ssq_q + MTOK;
#pragma unroll
          for (int i = 0; i < 8; ++i) rsv[i] = sp[row0 + (i >> 2) * 128 + (i & 3) * 16]; }
#pragma unroll
        for (int ai = 0; ai < 2; ++ai)
#pragma unroll
            for (int m = 0; m < 4; ++m) { const int row = row0 + ai * 128 + m * 16;
                const float rs = isq ? rsqrtf(rsv[ai * 4 + m] * (1.f / 256.f) + EPS) * 0.14724445f   : rsqrtf(rsv[ai * 4 + m] * (1.f / 128.f) + EPS);
                const float pos = (float)(row & 4095);
#pragma unroll
                for (int bj = 0; bj < 2; ++bj) { f32x4 v0 = acc[ai][bj][m][0] * rs, v1 = acc[ai][bj][m][1] * rs;
                    const int G = upn * 8 + bj * 4 + wc;
                    if (isq && (G % 3) == 2) {
#pragma unroll
                        for (int j = 0; j < 4; ++j) { const float ang = pos * rope_inv_freq(4 * fq + j); float c, s; sincos_fast(ang, s, c); const float a = v0[j], b = v1[j]; v0[j] = a * c - b * s; v1[j] = a * s + b * c; }
                    }
                    u32x2 w0, w1; w0.x = cvt_pk_bf16(v0[0], v0[1]); w0.y = cvt_pk_bf16(v0[2], v0[3]); w1.x = cvt_pk_bf16(v1[0], v1[1]); w1.y = cvt_pk_bf16(v1[2], v1[3]);
                    bf16_t* p = isq ? q + (size_t)row * 1536 + upn * 256 + bj * 128 + wc * 32 + 4 * fq : kv + (size_t)row * 2048 + (upn - 6) * 256 + bj * 128 + wc * 32 + 4 * fq;
                    *(u32x2*)p = w0; *(u32x2*)(p + 16) = w1; }
                __builtin_amdgcn_sched_barrier(0); }
    }
};

namespace att {
constexpr int NW = 8, QBLK = 32, KVBLK = 64;
constexpr float SCALE = 0.10206207261596575f;
constexpr float THR = 8.f;
constexpr int SHM_V = KVBLK * 64 * 2, SHM_K = KVBLK * 256;
#define KSWZ(row, colB) ((row) * 256 + ((colB) ^ (((row) & 7) << 4)))
#define SBAR() __builtin_amdgcn_sched_barrier(0)
__device__ __forceinline__ int crow(int r, int hi) { return (r & 3) + 8 * (r >> 2) + 4 * hi; }
constexpr float THR2 = THR * 1.4426950408889634f;
__device__ __forceinline__ void partialSM(f32x16& p0, f32x16& p1, float& m_ref, f32x16& negm, float& alpha, bool first) {
  float pmax = p0[0];
#pragma unroll
  for (int r = 1; r < 16; ++r) pmax = fmaxf(pmax, p0[r]);
#pragma unroll
  for (int r = 0; r < 16; ++r) pmax = fmaxf(pmax, p1[r]);
  { auto rr = __builtin_amdgcn_permlane32_swap(__float_as_uint(pmax), __float_as_uint(pmax), false, false);
    pmax = fmaxf(__uint_as_float(rr[0]), __uint_as_float(rr[1])); }
  if (__builtin_expect(!first && __all(pmax <= THR2), 1)) { alpha = 1.f; }
  else { const float dl = first ? pmax : fmaxf(pmax, 0.f); m_ref += dl; alpha = __builtin_amdgcn_exp2f(-dl);
#pragma unroll
    for (int r = 0; r < 16; ++r) { p0[r] -= dl; p1[r] -= dl; }
#pragma unroll
    for (int r = 0; r < 16; ++r) negm[r] = -m_ref; }
#pragma unroll
  for (int r = 0; r < 16; ++r) p0[r] = __builtin_amdgcn_exp2f(p0[r]);
}
__device__ __forceinline__ void finishSM(f32x16& p0, f32x16& p1, float alpha, float& l_reg, bf16x8& pa0, bf16x8& pa1, bf16x8& pa2, bf16x8& pa3) {
#pragma unroll
  for (int r = 0; r < 16; ++r) p1[r] = __builtin_amdgcn_exp2f(p1[r]);
  float ps = 0;
#pragma unroll
  for (int r = 0; r < 16; ++r) ps += p0[r];
#pragma unroll
  for (int r = 0; r < 16; ++r) ps += p1[r];
  { auto rr = __builtin_amdgcn_permlane32_swap(__float_as_uint(ps), __float_as_uint(ps), false, false);
    ps = __uint_as_float(rr[0]) + __uint_as_float(rr[1]); }
  l_reg = l_reg * alpha + ps;
#define PK4(P, BASE, OUT) do { u32x4 w = {cvt_pk_bf16(P[BASE + 0], P[BASE + 1]), cvt_pk_bf16(P[BASE + 2], P[BASE + 3]), \
    cvt_pk_bf16(P[BASE + 4], P[BASE + 5]), cvt_pk_bf16(P[BASE + 6], P[BASE + 7])}; OUT = *reinterpret_cast<bf16x8*>(&w); } while (0)
  PK4(p0, 0, pa0); PK4(p0, 8, pa1); PK4(p1, 0, pa2); PK4(p1, 8, pa3);
#undef PK4
}
__device__ __forceinline__ void qkt(f32x16& p0, f32x16& p1, const char* Ks, const bf16x8* qr, const f32x16& negm, int r32, int hi) {
  p0 = negm; p1 = negm;
#pragma unroll
  for (int d0 = 0; d0 < 6; ++d0) { int cb = (d0 * 16 + hi * 8) * 2;
    bf16x8 b0 = *reinterpret_cast<const bf16x8*>(Ks + KSWZ(r32, cb));
    bf16x8 b1 = *reinterpret_cast<const bf16x8*>(Ks + KSWZ(32 + r32, cb));
    p0 = __builtin_amdgcn_mfma_f32_32x32x16_bf16(b0, qr[d0], p0, 0, 0, 0);
    p1 = __builtin_amdgcn_mfma_f32_32x32x16_bf16(b1, qr[d0], p1, 0, 0, 0); }
}
__device__ __forceinline__ int v_st(int k, int c) { const int kk = k; return ((kk >> 3) * 2 + (c >> 5)) * 512 + ((kk & 7) * 32 + (c & 31)) * 2; }
__device__ __forceinline__ int v_rd_base(int lane) { return ((lane & 3) << 3) | (((lane >> 2) & 3) << 6) | (((lane >> 4) & 1) << 5) | (((lane >> 5) & 1) << 8); }
constexpr int v_rd_off(int d0, int ks, int half) { return d0 * 512 + ks * 2048 + half * 1024; }
template <int OFF> __device__ __forceinline__ s16x4 tr_read(int vb) {
  s16x4 r; asm volatile("ds_read_b64_tr_b16 %0, %1 offset:%2" : "=&v"(r) : "v"(vb), "i"(OFF) : "memory"); return r;
}
template <int D0> __device__ __forceinline__ void pv_one(f32x16& od, int vb, bf16x8 pa0, bf16x8 pa1, bf16x8 pa2, bf16x8 pa3) {
  const s16x4 l0 = tr_read<v_rd_off(D0, 0, 0)>(vb), h0 = tr_read<v_rd_off(D0, 0, 1)>(vb), l1 = tr_read<v_rd_off(D0, 1, 0)>(vb), h1 = tr_read<v_rd_off(D0, 1, 1)>(vb);
  const s16x4 l2 = tr_read<v_rd_off(D0, 2, 0)>(vb), h2 = tr_read<v_rd_off(D0, 2, 1)>(vb), l3 = tr_read<v_rd_off(D0, 3, 0)>(vb), h3 = tr_read<v_rd_off(D0, 3, 1)>(vb);
  asm volatile("s_waitcnt lgkmcnt(0)" ::: "memory"); SBAR();
#define PK(L, H) (bf16x8){L[0], L[1], L[2], L[3], H[0], H[1], H[2], H[3]}
  od = __builtin_amdgcn_mfma_f32_32x32x16_bf16(pa0, PK(l0, h0), od, 0, 0, 0);
  od = __builtin_amdgcn_mfma_f32_32x32x16_bf16(pa1, PK(l1, h1), od, 0, 0, 0);
  od = __builtin_amdgcn_mfma_f32_32x32x16_bf16(pa2, PK(l2, h2), od, 0, 0, 0);
  od = __builtin_amdgcn_mfma_f32_32x32x16_bf16(pa3, PK(l3, h3), od, 0, 0, 0);
#undef PK
}
__device__ __forceinline__ void pv_d0(f32x16* o, int vb, bf16x8 pa0, bf16x8 pa1, bf16x8 pa2, bf16x8 pa3) {
  pv_one<0>(o[0], vb, pa0, pa1, pa2, pa3); pv_one<1>(o[1], vb, pa0, pa1, pa2, pa3);
}
__device__ __forceinline__ void attn_unit(const bf16_t* __restrict__ Q, const bf16_t* __restrict__ KV, const bf16_t* __restrict__ KR, bf16_t* __restrict__ O, int b, int h, int qb, char* lds, int wv) {
  const int tid = tid_opaque(wv), wid = tid >> 6, lane = tid & 63, r32 = lane & 31, hi = lane >> 5;
  char* V_lds = lds; char* K_lds = lds + 2 * SHM_V;
  float* ws = (float*)(lds + 2 * SHM_V + 2 * SHM_K) + wid * 64; float* li_l = ws; float* al_l = ws + 32;
  float m_reg = 0.f, l_reg = 0; f32x16 o[2] = {}; bf16x8 qr[6]; f32x16 negm = {};
  const size_t rowbase = (size_t)b * SEQ;
  const bf16_t* Qw = Q + (rowbase + (size_t)qb * 256 + wid * QBLK + r32) * 1536 + h * 96 + hi * 8;
#pragma unroll
  for (int d0 = 0; d0 < 6; ++d0) qr[d0] = *reinterpret_cast<const bf16x8*>(Qw + d0 * 16);
  const int vr = tid >> 3, vc = (tid & 7) * 8, vst = v_st(vr, vc);
  const bf16_t* vsrc = KV + (rowbase + vr) * 2048 + h * 128 + 64 + vc;
  const int kc0 = tid & 15, kc = kc0 < 12 ? kc0 : kc0 - 4, sr = tid >> 4;
  const bf16_t* ksrc; size_t kstride;
  if (kc < 8) { ksrc = KV + (rowbase + sr) * 2048 + h * 128 + kc * 8; kstride = 2048; } else { ksrc = KR + (rowbase + sr) * 32 + (kc - 8) * 8; kstride = 32; }
  const int kst0 = KSWZ(sr, kc * 16), kst1 = KSWZ(32 + sr, kc * 16);
  const int vb0 = (int)(uintptr_t)V_lds + v_rd_base(lane);
  struct { bf16x8 vs, ks0, ks1; } sr_[2];
#define SLOAD(i, k0) do { sr_[i].vs = *reinterpret_cast<const bf16x8*>(vsrc + (size_t)(k0) * 2048); \
    sr_[i].ks0 = *reinterpret_cast<const bf16x8*>(ksrc + (size_t)(k0) * kstride); sr_[i].ks1 = *reinterpret_cast<const bf16x8*>(ksrc + (size_t)((k0) + 32) * kstride); } while (0)
#define SWRITE(bb, i) do { *(bf16x8*)(V_lds + (bb) * SHM_V + vst) = sr_[i].vs; \
    *(bf16x8*)(K_lds + (bb) * SHM_K + kst0) = sr_[i].ks0; *(bf16x8*)(K_lds + (bb) * SHM_K + kst1) = sr_[i].ks1; } while (0)
#define SWAIT() asm volatile("s_waitcnt vmcnt(3)" ::: "memory")
#define RESC(a) do { if (__any((a) < 1.f)) { if (hi == 0) al_l[r32] = (a); asm volatile("s_waitcnt lgkmcnt(0)" ::: "memory"); \
    _Pragma("unroll") for (int d = 0; d < 2; ++d) _Pragma("unroll") for (int r = 0; r < 16; ++r) o[d][r] *= al_l[crow(r, hi)]; } } while (0)
  f32x16 pA0, pA1, pB0, pB1; float alA, alB; bf16x8 pa0, pa1, pa2, pa3; const int NT = SEQ / KVBLK;
  constexpr int SE = 0, SO = 1;
  SLOAD(SE, 0); SLOAD(SO, KVBLK);
  SWAIT(); SWRITE(0, SE); __syncthreads();
  qkt(pA0, pA1, K_lds, qr, negm, r32, hi); partialSM(pA0, pA1, m_reg, negm, alA, true);
  SLOAD(SE, 2 * KVBLK);
  SWAIT(); SWRITE(1, SO); __syncthreads();
  for (int j = 1; j + 1 < NT; j += 2) {
    SBAR(); qkt(pB0, pB1, K_lds + SHM_K, qr, negm, r32, hi);
    finishSM(pA0, pA1, alA, l_reg, pa0, pa1, pa2, pa3); SBAR();
    SLOAD(SO, (j + 2) * KVBLK); SBAR();
    pv_d0(o, vb0, pa0, pa1, pa2, pa3); partialSM(pB0, pB1, m_reg, negm, alB, false);
    __syncthreads(); SWAIT(); SWRITE(0, SE);
    RESC(alB); __syncthreads();
    SBAR(); qkt(pA0, pA1, K_lds, qr, negm, r32, hi);
    finishSM(pB0, pB1, alB, l_reg, pa0, pa1, pa2, pa3); SBAR();
    if (j + 3 < NT) SLOAD(SE, (j + 3) * KVBLK); SBAR();
    pv_d0(o, vb0 + SHM_V, pa0, pa1, pa2, pa3); partialSM(pA0, pA1, m_reg, negm, alA, false);
    __syncthreads(); SWAIT(); SWRITE(1, SO);
    RESC(alA); __syncthreads();
  }
  SBAR(); qkt(pB0, pB1, K_lds + SHM_K, qr, negm, r32, hi);
  finishSM(pA0, pA1, alA, l_reg, pa0, pa1, pa2, pa3); SBAR();
  pv_d0(o, vb0, pa0, pa1, pa2, pa3); partialSM(pB0, pB1, m_reg, negm, alB, false);
  __syncthreads(); RESC(alB);
  finishSM(pB0, pB1, alB, l_reg, pa0, pa1, pa2, pa3); SBAR();
  pv_d0(o, vb0 + SHM_V, pa0, pa1, pa2, pa3);
  if (hi == 0) li_l[r32] = l_reg; asm volatile("s_waitcnt lgkmcnt(0)" ::: "memory");
  float rli[16];
#pragma unroll
  for (int r = 0; r < 16; ++r) rli[r] = __builtin_amdgcn_rcpf(li_l[crow(r, hi)]);
  bf16_t* Ow = O + (rowbase + (size_t)qb * 256 + wid * QBLK) * 1024 + h * 64;
#pragma unroll
  for (int r = 0; r < 16; ++r) { int orow = crow(r, hi);
#pragma unroll
    for (int d0 = 0; d0 < 2; ++d0) Ow[(size_t)orow * 1024 + d0 * 32 + r32] = (bf16_t)f2bf(o[d0][r] * rli[r]); }
  __syncthreads();
#undef SLOAD
#undef SWRITE
#undef SWAIT
#undef RESC
}
#undef SBAR
}

struct Args { const float* in[29]; float* out; unsigned char* ws; int ph_lo, ph_hi; };
typedef const __attribute__((address_space(4))) Args CArgs;
__device__ __forceinline__ CArgs* opaque_args() { auto p = __builtin_amdgcn_kernarg_segment_ptr(); asm volatile("" : "+s"(p)); return (CArgs*)p; }
enum { I_X = 0, I_NORMG, I_WG, I_WU, I_WDN, I_WIN, I_POOLW, I_POOLS, I_CONVW, I_CONVB, I_HW1, I_HB1, I_HW2, I_HB2, I_HW3, I_HB3, I_SINF, I_HWOUT, I_DECAY, I_HBIAS,
       I_WOUT, I_WDQ, I_QNG, I_WUQ, I_WDKV, I_KVNG, I_WUKV, I_WO, I_FNG };

__device__ __forceinline__ void p0_transpose_item(const float* W, int ldw, const float* gk, bf16_t* WT, int ldk, int koff, int rmode, int roff, LAS float* scr, int kb, int nb, int lane) {
    const int k0 = 64 * kb, n0 = 32 * nb;
    { const int ksub = lane >> 3, nq = lane & 7; f32x4 v[8]; float gg[8];
#pragma unroll
      for (int i = 0; i < 8; ++i) { const int kk = 8 * i + ksub; v[i] = *(const f32x4*)(W + (size_t)(k0 + kk) * ldw + n0 + 4 * nq); gg[i] = gk ? gk[k0 + kk] : 1.f; }
#pragma unroll
      for (int i = 0; i < 8; ++i) { const int kk = 8 * i + ksub; LAS float* d = scr + kk * 33 + 4 * nq; d[0] = v[i][0] * gg[i]; d[1] = v[i][1] * gg[i]; d[2] = v[i][2] * gg[i]; d[3] = v[i][3] * gg[i]; } }
    asm volatile("s_waitcnt lgkmcnt(0)" ::: "memory");
    const int c = lane & 7;
#pragma unroll
    for (int j = 0; j < 4; ++j) { const int n = (lane >> 3) + 8 * j; const LAS float* s = scr + (8 * c) * 33 + n;
        u32x4 o; o.x = cvt_pk_bf16(s[0 * 33], s[1 * 33]); o.y = cvt_pk_bf16(s[2 * 33], s[3 * 33]); o.z = cvt_pk_bf16(s[4 * 33], s[5 * 33]); o.w = cvt_pk_bf16(s[6 * 33], s[7 * 33]);
        const int ng = n0 + n; const int drow = rmode ? ((ng >> 7) * 256 + (ng & 127) + roff) : (ng + roff);
        *(u32x4*)(WT + (size_t)drow * ldk + koff + k0 + 8 * c) = o; }
    asm volatile("s_waitcnt lgkmcnt(0)" ::: "memory");
}

__device__ __forceinline__ void convert_jobs(CArgs& a, LAS unsigned char* lds, int sets, int gw, int NGW, int wv) {
    const int tid = tid_opaque(wv), lane = tid & 63, wave = tid >> 6;
    unsigned char* ws = a.ws;
    LAS float* scr = (LAS float*)(lds + wave * 16384);
    constexpr int IT_GU = 16 * 88, IT_DN = 44 * 32;
    constexpr int NITEMS = 4 * (2 * IT_GU + IT_DN) + 16 * 64 + 16 * 32 + 16 * 8 + 16 * 5 + 4 * 48 + 2 * 64 + 16 * 32;
    for (int it = gw; it < NITEMS; it += NGW) {
        int r = it; const float* W = nullptr; int ldw = 0, nblk = 1; const float* gk = nullptr; bf16_t* WT = nullptr; int ldk = 0, koff = 0, rmode = 0, roff = 0; bool found = false;
#define JOB(on_, ni_, W_, ldw_, gk_, WT_, ldk_, koff_, rmode_, roff_) if (!found && (on_)) { if (r < (ni_)) { W = (W_); ldw = (ldw_); nblk = (ldw_) / 32; gk = (gk_); WT = (WT_); ldk = (ldk_); koff = (koff_); rmode = (rmode_); roff = (roff_); found = true; } else r -= (ni_); }
#pragma unroll
        for (int f = 0; f < 4; ++f) { const float* g = a.in[I_NORMG] + ((f >> 1) * 3 + ((f & 1) ? 2 : 0)) * DM; const bool on = (sets >> f) & 1;
            JOB(on, IT_GU, a.in[I_WG] + (size_t)f * DM * FF, FF, g, (bf16_t*)(ws + WS_WGU) + (size_t)f * 5632 * DM, DM, 0, 1, 0)
            JOB(on, IT_GU, a.in[I_WU] + (size_t)f * DM * FF, FF, g, (bf16_t*)(ws + WS_WGU) + (size_t)f * 5632 * DM, DM, 0, 1, 128)
            JOB(on, IT_DN, a.in[I_WDN] + (size_t)f * DM * FF, DM, nullptr, (bf16_t*)(ws + WS_WD) + (size_t)f * DM * FF, FF, 0, 0, 0) }
        JOB(sets & 1, 16 * 64, a.in[I_WIN], 2048, a.in[I_NORMG] + 1 * DM, (bf16_t*)(ws + WS_WIN), DM, 0, 0, 0)
        JOB(sets & 1, 16 * 32, a.in[I_WOUT], DM, nullptr, (bf16_t*)(ws + WS_WOUT), DM, 0, 0, 0)
        JOB(sets & 4, 16 * 8, a.in[I_WDQ], 256, a.in[I_NORMG] + 4 * DM, (bf16_t*)(ws + WS_WD1), DM, 0, 0, 0)
        JOB(sets & 4, 16 * 5, a.in[I_WDKV], 160, a.in[I_NORMG] + 4 * DM, (bf16_t*)(ws + WS_WD1), DM, 0, 0, 256)
        JOB(sets & 4, 4 * 48, a.in[I_WUQ], 1536, a.in[I_QNG], (bf16_t*)(ws + WS_WUP), 384, 0, 0, 0)
        JOB(sets & 4, 2 * 64, a.in[I_WUKV], 2048, a.in[I_KVNG], (bf16_t*)(ws + WS_WUP), 384, 256, 0, 1536)
        JOB(sets & 4, 16 * 32, a.in[I_WO], DM, nullptr, (bf16_t*)(ws + WS_WO), DM, 0, 0, 0)
#undef JOB
        if (!found) break;
        p0_transpose_item(W, ldw, gk, WT, ldk, koff, rmode, roff, scr, r / nblk, r % nblk, lane);
    }
}
__device__ __forceinline__ void p0_prologue(CArgs& a, LAS unsigned char* lds, int G, int vcu, int wv) {
    const int tid = tid_opaque(wv), lane = tid & 63, wave = tid >> 6;
    unsigned char* ws = a.ws;
    const int gw = vcu * 8 + wave, NGW = G * 8;
    convert_jobs(a, lds, (G == 256) ? 1 : 15, gw, NGW, wv);
    const int gt = vcu * 512 + tid, GT = G * 512;
    { bf16_t* wd1 = (bf16_t*)(ws + WS_WD1) + 416 * DM; for (int i = gt; i < 96 * DM / 8; i += GT) ((u32x4*)wd1)[i] = (u32x4){0u, 0u, 0u, 0u};
      bf16_t* wup = (bf16_t*)(ws + WS_WUP);
      for (int i = gt; i < 1536 * 16; i += GT) { const int rr = i >> 4, c8 = i & 15; *(u32x4*)(wup + (size_t)rr * 384 + 256 + c8 * 8) = (u32x4){0u, 0u, 0u, 0u}; }
      for (int i = gt; i < 2048 * 32; i += GT) { const int rr = 1536 + (i >> 5), c8 = i & 31; *(u32x4*)(wup + (size_t)rr * 384 + c8 * 8) = (u32x4){0u, 0u, 0u, 0u}; } }
    { bf16_t* wp = (bf16_t*)(ws + WS_WPOOL); const float* pw = a.in[I_POOLW]; const float* ps = a.in[I_POOLS];
      for (int i = gt; i < 512 * 512; i += GT) { const int n = i >> 9, k = i & 511, g = n >> 7; float v = 0.f; if ((k >> 7) == g) v = pw[((size_t)g * 128 + (k & 127)) * 128 + (n & 127)] * ps[n]; wp[i] = (bf16_t)f2bf(v); } }
    { float* z = (float*)(ws + WS_SSQ) + MTOK; for (int i = gt; i < 7 * MTOK; i += GT) z[i] = 0.f;
      float* z2 = (float*)(ws + WS_SSQQ); for (int i = gt; i < 2 * MTOK; i += GT) z2[i] = 0.f;
      unsigned* pc = (unsigned*)(ws + WS_CNT); for (int i = gt; i < 64; i += GT) pc[i] = 0u; }
    { const float* x = a.in[I_X]; bf16_t* xb = (bf16_t*)(ws + WS_XB); float* ssq0 = (float*)(ws + WS_SSQ);
      for (int m0 = gw; m0 < MTOK; m0 += 4 * NGW) {
          f32x4 v[4][4];
#pragma unroll
          for (int r = 0; r < 4; ++r) { const int m = (m0 + r * NGW < MTOK) ? m0 + r * NGW : m0; const f32x4* xr = (const f32x4*)(x + (size_t)m * DM) + lane;
#pragma unroll
              for (int j = 0; j < 4; ++j) v[r][j] = xr[64 * j]; }
#pragma unroll
          for (int r = 0; r < 4; ++r) { const int m = m0 + r * NGW; if (m < MTOK) { float s = 0.f;
              unsigned long long* o8 = (unsigned long long*)(xb + (size_t)m * DM) + lane;
#pragma unroll
              for (int j = 0; j < 4; ++j) { const f32x4 q = v[r][j]; s += (q[0] * q[0] + q[1] * q[1]) + (q[2] * q[2] + q[3] * q[3]);
                  o8[64 * j] = (unsigned long long)cvt_pk_bf16(q[0], q[1]) | ((unsigned long long)cvt_pk_bf16(q[2], q[3]) << 32); }
              s = wave_sum(s); if (lane == 0) ssq0[m] = s; } } } }

    { float* hid3 = (float*)(ws + WS_HID3); const float* w1 = a.in[I_HW1]; const float* w2 = a.in[I_HW2]; const float* w3 = a.in[I_HW3]; const float* sf = a.in[I_SINF];
      const float b1 = a.in[I_HB1][lane], b2 = a.in[I_HB2][lane], b3 = a.in[I_HB3][lane], s1 = sf[lane], s2 = sf[64 + lane], s3 = sf[128 + lane];
      float w1r[33], w2r[64], w3r[64];
#pragma unroll
      for (int i = 0; i < 33; ++i) w1r[i] = w1[i * 64 + lane];
#pragma unroll
      for (int i = 0; i < 64; ++i) { w2r[i] = w2[i * 64 + lane]; w3r[i] = w3[i * 64 + lane]; }
      for (int t = gw; t < SEQ; t += NGW) {
          float z = 0.f;
          if (lane == 0) z = (float)t * (1.f / (float)(SEQ - 1));
          else if (lane < 33) { const int bnd = (lane - 1) & 15; const float wt = (6.283185307179586f * (float)t) / (float)SEQ; const float f = 1e-4f + (float)bnd * ((15.f - 1e-4f) / 15.f); const float ph = wt * f;
              z = (lane < 17) ? cosf(ph) : -sinf(ph); }
          float acc1 = b1;
#pragma unroll
          for (int i = 0; i < 33; ++i) acc1 += __builtin_bit_cast(float, __builtin_amdgcn_readlane(__builtin_bit_cast(int, z), i)) * w1r[i];
          const float h1 = sinf(s1 * acc1);
          float acc2 = b2;
#pragma unroll
          for (int i = 0; i < 64; ++i) acc2 += __builtin_bit_cast(float, __builtin_amdgcn_readlane(__builtin_bit_cast(int, h1), i)) * w2r[i];
          const float h2 = sinf(s2 * acc2);
          float acc3 = b3;
#pragma unroll
          for (int i = 0; i < 64; ++i) acc3 += __builtin_bit_cast(float, __builtin_amdgcn_readlane(__builtin_bit_cast(int, h2), i)) * w3r[i];
          hid3[(size_t)t * 64 + lane] = sinf(s3 * acc3);
      } }
}

template <int HW> __device__ __forceinline__ void pool_chunk(const bf16_t* a, bf16_t* out, int t0) {
    float v[64 + 2 * HW];
#pragma unroll
    for (int i = 0; i < 64 + 2 * HW; ++i) { const int s = t0 - HW + i; const int sc = s < 0 ? 0 : (s > SEQ - 1 ? SEQ - 1 : s); const float x = bf2f(a[(size_t)sc * 512]); v[i] = (s == sc) ? x : 0.f; }
    float S = 0.f;
#pragma unroll
    for (int i = 0; i < 2 * HW; ++i) S += v[i];
#pragma unroll
    for (int j = 0; j < 64; ++j) { const int t = t0 + j; const int lo = (t - HW) > 0 ? (t - HW) : 0, hi = (t + HW) < SEQ ? (t + HW) : SEQ;
        out[(size_t)t * 512] = (bf16_t)f2bf(S * __builtin_amdgcn_rcpf((float)(hi - lo)) - v[HW + j]);
        S += v[j + 2 * HW] - v[j]; }
}
__device__ __forceinline__ void pool_item(const bf16_t* apool, bf16_t* pp, int item, int wv) {
    const int c = tid_opaque(wv), g = wv >> 1;
    const int b = item >> 6, t0 = (item & 63) * 64;
    const bf16_t* a = apool + (size_t)b * SEQ * 512 + c; bf16_t* o = pp + (size_t)b * SEQ * 512 + c;
    if (g == 0) pool_chunk<1>(a, o, t0); else if (g == 1) pool_chunk<2>(a, o, t0); else if (g == 2) pool_chunk<4>(a, o, t0); else pool_chunk<8>(a, o, t0);
}

#define HD __device__ __forceinline__
#define LDSP LAS
#ifdef __HIPCC__
typedef float cf __attribute__((ext_vector_type(2)));
#else
#ifndef CF_HOST_DEFINED
#define CF_HOST_DEFINED
struct cf { float x, y; };
#endif
#endif
#ifdef __HIPCC__
HD cf cmul(cf a, cf b) { cf t, r;
    asm("v_pk_mul_f32 %0, %1, %2 op_sel_hi:[1,0]" : "=v"(t) : "v"(a), "v"(b));
    asm("v_pk_fma_f32 %0, %1, %2, %3 op_sel:[1,1,0] op_sel_hi:[0,1,1] neg_lo:[1,0,0]" : "=v"(r) : "v"(a), "v"(b), "v"(t));
    return r; }
HD cf cmulc(cf a, cf b) { cf t, r;
    asm("v_pk_mul_f32 %0, %1, %2 op_sel_hi:[1,0]" : "=v"(t) : "v"(a), "v"(b));
    asm("v_pk_fma_f32 %0, %1, %2, %3 op_sel:[1,1,0] op_sel_hi:[0,1,1] neg_hi:[1,0,0]" : "=v"(r) : "v"(a), "v"(b), "v"(t));
    return r; }
HD cf cmul_s(cf a, cf b) { cf t, r;
    asm("v_pk_mul_f32 %0, %1, %2 op_sel_hi:[1,0]" : "=v"(t) : "v"(a), "s"(b));
    asm("v_pk_fma_f32 %0, %1, %2, %3 op_sel:[1,1,0] op_sel_hi:[0,1,1] neg_lo:[1,0,0]" : "=v"(r) : "v"(a), "s"(b), "v"(t));
    return r; }
HD cf cmulc_s(cf a, cf b) { cf t, r;
    asm("v_pk_mul_f32 %0, %1, %2 op_sel_hi:[1,0]" : "=v"(t) : "v"(a), "s"(b));
    asm("v_pk_fma_f32 %0, %1, %2, %3 op_sel:[1,1,0] op_sel_hi:[0,1,1] neg_hi:[1,0,0]" : "=v"(r) : "v"(a), "s"(b), "v"(t));
    return r; }
#else
HD cf cmul_s(cf a, cf b) { cf r; r.x = a.x * b.x - a.y * b.y; r.y = a.x * b.y + a.y * b.x; return r; }
HD cf cmulc_s(cf a, cf b) { cf r; r.x = a.x * b.x + a.y * b.y; r.y = a.y * b.x - a.x * b.y; return r; }
HD cf cmul(cf a, cf b) { cf r; r.x = a.x * b.x - a.y * b.y; r.y = a.x * b.y + a.y * b.x; return r; }
HD cf cmulc(cf a, cf b) { cf r; r.x = a.x * b.x + a.y * b.y; r.y = a.y * b.x - a.x * b.y; return r; }
#endif
HD cf cadd(cf a, cf b) { cf r; r.x = a.x + b.x; r.y = a.y + b.y; return r; }
HD cf csub(cf a, cf b) { cf r; r.x = a.x - b.x; r.y = a.y - b.y; return r; }
HD int PADI(int i) { return i + (i >> 4); }
template <int X> HD cf c16() {
    constexpr float C[8] = {1.f, 0.92387953251128674f, 0.70710678118654752f, 0.38268343236508977f, 0.f, -0.38268343236508977f, -0.70710678118654752f, -0.92387953251128674f};
    constexpr float S[8] = {0.f, -0.38268343236508977f, -0.70710678118654752f, -0.92387953251128674f, -1.f, -0.92387953251128674f, -0.70710678118654752f, -0.38268343236508977f};
    cf r; r.x = C[X]; r.y = S[X]; return r;
}
template <int X, bool CONJ> HD cf mulc16(cf v) {
    constexpr float R = 0.70710678118654752f; cf r;
    if constexpr (X == 0) { r = v; }
    else if constexpr (X == 4) {
#ifdef __HIPCC__
        cf c; c.x = CONJ ? -1.f : 1.f; c.y = CONJ ? 1.f : -1.f;
        asm("v_pk_mul_f32 %0, %1, %2 op_sel:[1,0] op_sel_hi:[0,1]" : "=v"(r) : "v"(v), "s"(c));
#else
        if (!CONJ) { r.x = v.y; r.y = -v.x; } else { r.x = -v.y; r.y = v.x; }
#endif
    }
    else { const cf c = c16<X>(); r = CONJ ? cmulc_s(v, c) : cmul_s(v, c); }
    return r;
}
template <int J, int Q, int I, bool INV> HD void bfly(cf (&v)[16]) {
    constexpr int hk = 8 >> J; constexpr int X = I * (8 / hk);
    const cf a = v[Q + I], b = v[Q + I + hk];
    if (!INV) { v[Q + I] = cadd(a, b); v[Q + I + hk] = mulc16<X, false>(csub(a, b)); }
    else { const cf bb = mulc16<X, true>(b); v[Q + I] = cadd(a, bb); v[Q + I + hk] = csub(a, bb); }
}
template <int J, bool INV> HD void stage16(cf (&v)[16]) {
    if constexpr (J == 0) { bfly<0,0,0,INV>(v); bfly<0,0,1,INV>(v); bfly<0,0,2,INV>(v); bfly<0,0,3,INV>(v); bfly<0,0,4,INV>(v); bfly<0,0,5,INV>(v); bfly<0,0,6,INV>(v); bfly<0,0,7,INV>(v); }
    if constexpr (J == 1) { bfly<1,0,0,INV>(v); bfly<1,0,1,INV>(v); bfly<1,0,2,INV>(v); bfly<1,0,3,INV>(v); bfly<1,8,0,INV>(v); bfly<1,8,1,INV>(v); bfly<1,8,2,INV>(v); bfly<1,8,3,INV>(v); }
    if constexpr (J == 2) { bfly<2,0,0,INV>(v); bfly<2,0,1,INV>(v); bfly<2,4,0,INV>(v); bfly<2,4,1,INV>(v); bfly<2,8,0,INV>(v); bfly<2,8,1,INV>(v); bfly<2,12,0,INV>(v); bfly<2,12,1,INV>(v); }
    if constexpr (J == 3) { bfly<3,0,0,INV>(v); bfly<3,2,0,INV>(v); bfly<3,4,0,INV>(v); bfly<3,6,0,INV>(v); bfly<3,8,0,INV>(v); bfly<3,10,0,INV>(v); bfly<3,12,0,INV>(v); bfly<3,14,0,INV>(v); }
}
constexpr int bitrev4(int k) { return ((k & 1) << 3) | ((k & 2) << 1) | ((k & 4) >> 1) | ((k & 8) >> 3); }
template <int M_LAST, bool INV> HD void fft_pass16(LDSP cf* buf, int g, cf W) {
    const int lo = g & (M_LAST - 1); const int base = (g / M_LAST) * (M_LAST * 16) + lo;
    cf v[16];
#pragma unroll
    for (int k = 0; k < 16; ++k) v[k] = buf[PADI(base + k * M_LAST)];
#ifdef __HIPCC__
    asm volatile("" : "+v"(W));
#endif
    if (!INV) { stage16<0, false>(v); stage16<1, false>(v); stage16<2, false>(v); stage16<3, false>(v);
        cf cur = W;
#pragma unroll
        for (int e = 1; e < 16; ++e) { v[bitrev4(e)] = cmul(v[bitrev4(e)], cur); if (e < 15) cur = cmul(cur, W); } }
    else {
        cf cur = W;
#pragma unroll
        for (int e = 1; e < 16; ++e) { v[bitrev4(e)] = cmulc(v[bitrev4(e)], cur); if (e < 15) cur = cmul(cur, W); }
        stage16<3, true>(v); stage16<2, true>(v); stage16<1, true>(v); stage16<0, true>(v); }
#pragma unroll
    for (int k = 0; k < 16; ++k) buf[PADI(base + k * M_LAST)] = v[k];
}
HD void fft_last_scale(LDSP cf* buf, int g, float sc) {
#pragma unroll
    for (int p = 0; p < 8; ++p) { const int i0 = PADI(16 * g + 2 * p), i1 = PADI(16 * g + 2 * p + 1); const cf a = buf[i0], b = buf[i1];
        cf s = cadd(a, b), d = csub(a, b); s.x *= sc; s.y *= sc; d.x *= sc; d.y *= sc; buf[i0] = s; buf[i1] = d; }
}
HD void fft_middle(LDSP cf* buf, const LDSP cf* H, int g) {
#pragma unroll
    for (int p = 0; p < 8; ++p) { const int i0 = PADI(16 * g + 2 * p), i1 = PADI(16 * g + 2 * p + 1); const cf a = buf[i0], b = buf[i1];
        const cf s = cmul(cadd(a, b), H[i0]), d = cmul(csub(a, b), H[i1]); buf[i0] = cadd(s, d); buf[i1] = csub(s, d); }
}
#undef HD
#undef LDSP
__device__ __forceinline__ cf tw_of(float frac) { cf r; r.x = __builtin_amdgcn_cosf(frac); r.y = -__builtin_amdgcn_sinf(frac); return r; }
__device__ __forceinline__ float xshfl(float v, int o, int l) { return __builtin_bit_cast(float, __builtin_amdgcn_ds_bpermute((l ^ o) << 2, __builtin_bit_cast(int, v))); }
__device__ __forceinline__ void fft_fwd3(LAS cf* buf, int tid, cf W0, cf W1, cf W2) {
    fft_pass16<512, false>(buf, tid, W0); __syncthreads(); fft_pass16<32, false>(buf, tid, W1); __syncthreads(); fft_pass16<2, false>(buf, tid, W2); __syncthreads();
}
__device__ __forceinline__ void fft_inv3(LAS cf* buf, int tid, cf W0, cf W1, cf W2) {
    fft_pass16<2, true>(buf, tid, W2); __syncthreads(); fft_pass16<32, true>(buf, tid, W1); __syncthreads(); fft_pass16<512, true>(buf, tid, W0); __syncthreads();
}
__device__ __forceinline__ float block_sum(float v, LAS float* red, int tid) {
    v = wave_sum(v); __syncthreads(); if ((tid & 63) == 0) red[tid >> 6] = v; __syncthreads();
    float s = 0.f;
#pragma unroll
    for (int i = 0; i < 8; ++i) s += red[i];
    return s;
}
__device__ __forceinline__ float sconv(const bf16_t* uc, int b, int ch, int t, float w0, float w1, float w2, float cb) {
    const bf16_t* u = uc + (((size_t)(b * 1536 + ch)) << 12) + t;
    const float xm = bf2f(u[t > 0 ? -1 : 0]), u0 = bf2f(u[0]), xp = bf2f(u[t < SEQ - 1 ? 1 : 0]);
    const float um = t > 0 ? xm : 0.f, up = t < SEQ - 1 ? xp : 0.f;
    return cb + w0 * um + w1 * u0 + w2 * up;
}
__device__ __forceinline__ void sconv8(const bf16_t* uc, int b, int ch, int tid, float w0, float w1, float w2, float cb, float (&out)[8]) {
    const bf16_t* u = uc + (((size_t)(b * 1536 + ch)) << 12) + 8 * tid;
    const u32x4 raw = *(const u32x4*)u;
    const float pv = bf2f(u[tid > 0 ? -1 : 0]), nx = bf2f(u[tid < 511 ? 8 : 7]);
    float x[10]; x[0] = tid > 0 ? pv : 0.f; x[9] = tid < 511 ? nx : 0.f;
#pragma unroll
    for (int i = 0; i < 4; ++i) { x[1 + 2 * i] = __builtin_bit_cast(float, raw[i] << 16); x[2 + 2 * i] = __builtin_bit_cast(float, raw[i] & 0xffff0000u); }
#pragma unroll
    for (int j = 0; j < 8; ++j) out[j] = cb + w0 * x[j] + w1 * x[j + 1] + w2 * x[j + 2];
}
__device__ __forceinline__ void hyena_block(CArgs& a, LAS unsigned char* lds, int blk, int wv) {
    const int tid = tid_opaque(wv);
    unsigned char* ws = a.ws;
    LAS cf* A = (LAS cf*)lds; LAS cf* Hb = (LAS cf*)(lds + FFT_BUF); LAS float* wl = (LAS float*)(lds + 2 * FFT_BUF); LAS float* red = wl + 512; LAS float* scl = red + 8;
    const float* hid3 = (const float*)(ws + WS_HID3); const bf16_t* uc = (const bf16_t*)(ws + WS_UC); bf16_t* yc = (bf16_t*)(ws + WS_YC);
    float* fs = a.out + (size_t)blk * 4 * 8192;
    cf* z1 = (cf*)(ws + WS_Z1) + (size_t)blk * 2 * 4096;
    const cf W0 = tw_of((float)tid * (1.f / 8192.f)), W1 = tw_of((float)(tid & 31) * (1.f / 512.f)), W2 = tw_of((float)(tid & 1) * (1.f / 32.f));
#ifndef PROBE_PHASE
#define PROBE_PHASE -1
#endif
    for (int rp = 0; rp < ((PROBE_PHASE == 41) ? 2 : 1); ++rp) {
    __syncthreads();
    { const int f = tid >> 6, j = tid & 63, ci = f >> 2, o = (f >> 1) & 1, dir = f & 1;
      wl[tid] = a.in[I_HWOUT][(size_t)j * 2048 + o * 1024 + dir * 512 + blk + ci * 256]; }
    __syncthreads();
    LAS float* F = (LAS float*)lds;
    float ssq_l = 0.f;
    { const int lane = tid & 63, wvv = tid >> 6, rsub = lane >> 4, q = lane & 15, fsel = q >> 1, fo = fsel >> 1, dir = fsel & 1;
      int lop = lane; asm volatile("" : "+v"(lop));
      f32x4 w[8];
#pragma unroll
      for (int f = 0; f < 8; ++f) w[f] = *(const LAS f32x4*)(wl + f * 64 + 4 * q);
      const float mydec = fabsf(a.in[I_DECAY][(((fsel >> 1) & 1) * 2 + dir) * 512 + blk + (fsel >> 2) * 256]);
      const float* hbase = hid3 + (size_t)(512 * wvv + rsub) * 64 + 4 * q;
#define SWEEP_LOAD(HB, IB) do { _Pragma("unroll") for (int ii = 0; ii < 16; ++ii) HB[ii] = *(const f32x4*)(hbase + (size_t)(16 * (IB) + ii) * 256); } while (0)
#define SWEEP_PROC(HB, IB) do { _Pragma("unroll") for (int ii = 0; ii < 16; ++ii) { const int it = 16 * (IB) + ii; const int row = 512 * wvv + 4 * it + rsub; const f32x4 h = HB[ii]; \
          float p[8]; \
          _Pragma("unroll") for (int f = 0; f < 8; ++f) p[f] = (h[0] * w[f][0] + h[1] * w[f][1]) + (h[2] * w[f][2] + h[3] * w[f][3]); \
          float p1[4], p2[2]; \
          _Pragma("unroll") for (int jj = 0; jj < 4; ++jj) { const float snd = (q & 8) ? p[jj] : p[jj + 4], kp = (q & 8) ? p[jj + 4] : p[jj]; p1[jj] = kp + xshfl(snd, 8, lop); } \
          _Pragma("unroll") for (int jj = 0; jj < 2; ++jj) { const float snd = (q & 4) ? p1[jj] : p1[jj + 2], kp = (q & 4) ? p1[jj + 2] : p1[jj]; p2[jj] = kp + xshfl(snd, 4, lop); } \
          float p3; { const float snd = (q & 2) ? p2[0] : p2[1], kp = (q & 2) ? p2[1] : p2[0]; p3 = kp + xshfl(snd, 2, lop); } \
          p3 += xshfl(p3, 1, lop); \
          if ((q & 1) == 0) { const float tt = (float)row * (1.f / (float)(SEQ - 1)); float val = p3 * __expf(-tt * mydec); \
              int idx = dir ? 8192 - row : row; if (dir && row == 0) { idx = 4096; val = 0.f; } \
              F[(fsel >> 1) * 8192 + idx] = val; ssq_l += val * val; } } } while (0)
      { f32x4 hbA[16], hbB[16];
        SWEEP_LOAD(hbA, 0);
#pragma unroll 1
        for (int ib = 0; ib < 8; ib += 2) { SWEEP_LOAD(hbB, ib + 1); SWEEP_PROC(hbA, ib); if (ib + 2 < 8) SWEEP_LOAD(hbA, ib + 2); SWEEP_PROC(hbB, ib + 1); } }
#undef SWEEP_LOAD
#undef SWEEP_PROC
#pragma unroll
      for (int k = 0; k < 4; ++k) { const float s = block_sum(((q & 1) == 0 && (fsel >> 1) == k) ? ssq_l : 0.f, red, tid); if (tid == 0) scl[k] = rsqrtf(s) * (1.f / 8192.f); }
    }
    __syncthreads();
#pragma unroll
    for (int fo = 0; fo < 4; ++fo) { float* dst = fs + (size_t)fo * 8192; const LAS float* src = F + fo * 8192;
#pragma unroll
        for (int i = 0; i < 8; ++i) { const int t = tid + 512 * i; dst[t] = src[t]; if (t >= 1) dst[8192 - t] = src[8192 - t]; else dst[4096] = 0.f; } }
    __syncthreads();
    }
    const float* cw = a.in[I_CONVW]; const float* cbv = a.in[I_CONVB];
    for (int ci = 0; ci < 2; ++ci) { const int c = blk + ci * 256;
        for (int o = 0; o < 2; ++o) {
            { const float* src = fs + (size_t)(ci * 2 + o) * 8192; float fa[8], fb[8];
#pragma unroll
              for (int i = 0; i < 8; ++i) { const int t = tid + 512 * i, tb = t >= 1 ? 8192 - t : 4096; fa[i] = src[t]; fb[i] = src[tb]; }
#pragma unroll
              for (int i = 0; i < 8; ++i) { const int t = tid + 512 * i, tb = t >= 1 ? 8192 - t : 4096; cf v; v.y = 0.f; v.x = fa[i]; Hb[PADI(t)] = v; v.x = fb[i]; Hb[PADI(tb)] = v; } }
            __syncthreads();
#if PROBE_PHASE == 42
            fft_fwd3(Hb, tid, W0, W1, W2); fft_inv3(Hb, tid, W0, W1, W2);
            fft_fwd3(Hb, tid, W0, W1, W2);
            fft_last_scale(Hb, tid, scl[ci * 2 + o] * (1.f / 4096.f));
#else
            fft_fwd3(Hb, tid, W0, W1, W2);
            fft_last_scale(Hb, tid, scl[ci * 2 + o]);
#endif
            __syncthreads();
            const int zch = 1024 + c, gch = o * 512 + c;
            const float zw0 = cw[zch], zw1 = cw[1536 + zch], zw2 = cw[3072 + zch], zcb = cbv[zch];
            const float gw0 = cw[gch], gw1 = cw[1536 + gch], gw2 = cw[3072 + gch], gcb = cbv[gch];
            const float bias = a.in[I_HBIAS][o * 512 + c];
            for (int bp = 0; bp < 2; ++bp) { const int b0 = 2 * bp, b1 = 2 * bp + 1;
                cf zz[8];
                { if (o == 0) { float za[8], zb[8]; sconv8(uc, b0, zch, tid, zw0, zw1, zw2, zcb, za); sconv8(uc, b1, zch, tid, zw0, zw1, zw2, zcb, zb);
#pragma unroll
                      for (int j = 0; j < 8; ++j) { zz[j].x = za[j]; zz[j].y = zb[j]; } }
                  else { const f32x4* zp = (const f32x4*)(z1 + bp * 4096 + 8 * tid);
#pragma unroll
                      for (int j = 0; j < 4; ++j) { const f32x4 q4 = zp[j]; zz[2 * j].x = q4[0]; zz[2 * j].y = q4[1]; zz[2 * j + 1].x = q4[2]; zz[2 * j + 1].y = q4[3]; } }
#pragma unroll
                  for (int j = 0; j < 8; ++j) { A[PADI(8 * tid + j)] = zz[j]; cf zero; zero.x = 0.f; zero.y = 0.f; A[PADI(4096 + 8 * tid + j)] = zero; } }
                float ga[8], gb[8]; sconv8(uc, b0, gch, tid, gw0, gw1, gw2, gcb, ga); sconv8(uc, b1, gch, tid, gw0, gw1, gw2, gcb, gb);
                __syncthreads();
                fft_fwd3(A, tid, W0, W1, W2);
                fft_middle(A, Hb, tid); __syncthreads();
                fft_inv3(A, tid, W0, W1, W2);
                {
                  float r0[8], r1[8];
#pragma unroll
                  for (int j = 0; j < 8; ++j) { const cf y = A[PADI(8 * tid + j)]; r0[j] = ga[j] * (y.x + zz[j].x * bias); r1[j] = gb[j] * (y.y + zz[j].y * bias); }
                  if (o == 0) { f32x4* zp = (f32x4*)(z1 + bp * 4096 + 8 * tid);
#pragma unroll
                      for (int j = 0; j < 4; ++j) zp[j] = (f32x4){r0[2 * j], r1[2 * j], r0[2 * j + 1], r1[2 * j + 1]}; }
                  else { u32x4 w0v, w1v;
#pragma unroll
                      for (int j = 0; j < 4; ++j) { w0v[j] = cvt_pk_bf16(r0[2 * j], r0[2 * j + 1]); w1v[j] = cvt_pk_bf16(r1[2 * j], r1[2 * j + 1]); }
                      *(u32x4*)(yc + (((size_t)(b0 * 512 + c)) << 12) + 8 * tid) = w0v; *(u32x4*)(yc + (((size_t)(b1 * 512 + c)) << 12) + 8 * tid) = w1v; } }
                __syncthreads();
            }
        }
    }
}
__device__ __forceinline__ void transpose_tiles(const bf16_t* yc, bf16_t* y, LAS unsigned char* lds, int nblk, int iblk, int wv) {
    const int tid = tid_opaque(wv), lane = tid & 63, wave = tid >> 6;
    LAS bf16_t* s = (LAS bf16_t*)(lds + wave * 16384);
    for (int tile = iblk * 8 + wave; tile < 4 * 8 * 64; tile += nblk * 8) { const int b = tile >> 9, cb = (tile >> 6) & 7, tb = tile & 63;
        const bf16_t* src = yc + (((size_t)(b * 512 + cb * 64)) << 12) + tb * 64 + lane;
        bf16_t tv[64];
#pragma unroll
        for (int i = 0; i < 64; ++i) tv[i] = src[(size_t)i << 12];
#pragma unroll
        for (int i = 0; i < 64; ++i) s[i * 66 + lane] = tv[i];
        asm volatile("s_waitcnt lgkmcnt(0)" ::: "memory");
        bf16_t* dst = y + ((size_t)b * SEQ + tb * 64) * 1024 + 512 + cb * 64 + lane;
#pragma unroll 8
        for (int i = 0; i < 64; ++i) dst[(size_t)i * 1024] = s[lane * 66 + i];
        asm volatile("s_waitcnt lgkmcnt(0)" ::: "memory");
    }
}

#define XB_TMO      128
#define XB_XCNT(j)  (256  + 64 * (j))
#define XB_XSUB(j)  (1280 + 64 * (j))
#define XB_XGEN(j)  (2304 + 64 * (j))
#define XB_TOP      3328
#define XB_TOPGEN   3392
#define XCD_BAR_WORDS 3456
#define XB_SPIN_CAP (1u << 18)
__device__ __forceinline__ unsigned xb_ld(unsigned* p)              { return __hip_atomic_load(p, __ATOMIC_RELAXED, __HIP_MEMORY_SCOPE_AGENT); }
__device__ __forceinline__ unsigned xb_add(unsigned* p, unsigned v) { return __hip_atomic_fetch_add(p, v, __ATOMIC_RELAXED, __HIP_MEMORY_SCOPE_AGENT); }
__device__ __forceinline__ unsigned xb_xcc_id() { return (unsigned)__builtin_amdgcn_s_getreg((3 << 11) | 20) & 0xFu; }
#define XB_SPIN(cond, bar) do { unsigned _sp = 0; while (cond) { __builtin_amdgcn_s_sleep(1); \
    if ((++_sp & 255u) == 0u) { if (xb_ld(&(bar)[XB_TMO])) break; if (_sp > XB_SPIN_CAP) { atomicAdd(&(bar)[XB_TMO], 1u); break; } } } } while (0)
struct XcdBarrier { unsigned* bar; unsigned x; volatile LAS unsigned* st; };
__device__ __forceinline__ XcdBarrier xcd_barrier_post(unsigned* bar, volatile LAS unsigned* st) {
    XcdBarrier b; b.bar = bar; b.x = xb_xcc_id(); b.st = st;
    if (threadIdx.x == 0) (void)xb_add(&bar[XB_XCNT(b.x)], 1u);
    return b;
}
__device__ __forceinline__ void xcd_barrier_complete(unsigned* bar, unsigned x, unsigned& nloc, unsigned& nx) {
    const unsigned G = gridDim.x * gridDim.y * gridDim.z;
    unsigned sum, cnt, mine, sp = 0u;
    for (;;) {
        sum = 0u; cnt = 0u; mine = 0u;
#pragma unroll
        for (unsigned j = 0; j < 16; ++j) { const unsigned c = xb_ld(&bar[XB_XCNT(j)]); sum += c; cnt += (c > 0u) ? 1u : 0u; mine = (j == x) ? c : mine; }
        if (sum == G) break;
        __builtin_amdgcn_s_sleep(1);
        if ((++sp & 255u) == 0u) { if (xb_ld(&bar[XB_TMO])) break; if (sp > XB_SPIN_CAP) { atomicAdd(&bar[XB_TMO], 1u); break; } }
    }
    nloc = mine > 0u ? mine : 1u; nx = cnt > 0u ? cnt : 1u;
}
__device__ __forceinline__ void xcd_barrier(unsigned* bar_, volatile LAS unsigned* st_, int wv) {
    XcdBarrier b; b.bar = bar_; b.st = st_; b.x = 0u;
    asm volatile("s_waitcnt vmcnt(0)" ::: "memory");
    __syncthreads();
    if (tid_opaque(wv) == 0) {
        unsigned* bar = b.bar; b.x = xb_xcc_id();
        __builtin_amdgcn_s_waitcnt(0);
        unsigned nloc = b.st[0], nx = b.st[1];
        if (nloc == 0u) { xcd_barrier_complete(bar, b.x, nloc, nx); b.st[0] = nloc; b.st[1] = nx; }
        const unsigned old = xb_add(&bar[XB_XSUB(b.x)], 1u);
        const unsigned gen = old / nloc;
        if (old + 1u == (gen + 1u) * nloc) {
            __builtin_amdgcn_fence(__ATOMIC_RELEASE, "agent");
            asm volatile("s_waitcnt vmcnt(0)" ::: "memory");
            const unsigned og = xb_add(&bar[XB_TOP], 1u);
            const unsigned tg = og / nx;
            if (og + 1u == (tg + 1u) * nx) xb_add(&bar[XB_TOPGEN], 1u);
            else XB_SPIN(xb_ld(&bar[XB_TOPGEN]) == tg, bar);
            __builtin_amdgcn_fence(__ATOMIC_ACQUIRE, "agent");
            xb_add(&bar[XB_XGEN(b.x)], 1u);
            asm volatile("s_waitcnt vmcnt(0)" ::: "memory");
        } else {
            XB_SPIN(xb_ld(&bar[XB_XGEN(b.x)]) == gen, bar);
            __builtin_amdgcn_fence(__ATOMIC_ACQUIRE, "agent");
            asm volatile("s_waitcnt vmcnt(0)" ::: "memory");
        }
    }
    __syncthreads();
}

constexpr int NPH = 18;
__global__ void __launch_bounds__(512, 2) mega_fwd(Args a) {
    extern __shared__ __attribute__((aligned(16))) unsigned char lds_raw[];
    cg::grid_group grid = cg::this_grid();
    LAS unsigned char* lds = (LAS unsigned char*)lds_raw;
    const int G = gridDim.x, bx = blockIdx.x;
    const int wv = __builtin_amdgcn_readfirstlane((int)(threadIdx.x >> 6));
    const int vcu = (G % 8 == 0) ? (bx % 8) * (G / 8) + bx / 8 : bx;
    unsigned char* ws = a.ws;
    float* ssq = (float*)(ws + WS_SSQ); float* ssq_q = (float*)(ws + WS_SSQQ); float* ssq_kv = (float*)(ws + WS_SSQKV);
    bf16_t* XB = (bf16_t*)(ws + WS_XB); bf16_t* ACT = (bf16_t*)(ws + WS_ACT);
    float* X = a.out;
    const int lo = a.ph_lo, hi = a.ph_hi;
    volatile LAS unsigned* bst = (volatile LAS unsigned*)(lds + LDS_BYTES - 16);
    if (threadIdx.x < 2) bst[threadIdx.x] = 0u;
    __syncthreads();
    (void)xcd_barrier_post((unsigned*)(ws + WS_BAR), bst);
    if (lo < 0) grid.sync();
#ifndef PH_MASK
#define PH_MASK 0x3ffff
#endif
#define IN(k) ((((PH_MASK) >> (k)) & 1) && lo <= (k) && (k) < hi)
#ifndef PROBE_PHASE
#define PROBE_PHASE -1
#endif
#ifndef PROBE_SYNC
#define PROBE_SYNC 0
#endif
#define NREP(k) (((k) == PROBE_PHASE) ? 2 : 1)
#define SEAM(k) do { if (IN(k) && IN((k) + 1)) { xcd_barrier((unsigned*)(ws + WS_BAR), bst, wv); if (PROBE_SYNC) xcd_barrier((unsigned*)(ws + WS_BAR), bst, wv); } } while (0)
#define FFN_UP(k, f, sidx) if (IN(k)) for (int rep = 0; rep < NREP(k); ++rep) { pg8::Gemm g{XB, (const bf16_t*)(ws + WS_WGU) + (size_t)(f) * 5632 * DM, MTOK, 5632, DM, DM}; pg8::StaticOrder S; S.init(MTOK, 5632, G, bx); \
        EpiAct E{ACT, ssq + (sidx) * MTOK}; pg8::gemm_phase<EpiAct, pg8::StaticOrder, true, true>(lds, g, S, E, wv); }
#define FFN_DN(k, f, xin_, sidx) if (IN(k)) { pg8::Gemm g{ACT, (const bf16_t*)(ws + WS_WD) + (size_t)(f) * DM * FF, MTOK, DM, FF, FF}; pg8::StaticOrder S; S.init(MTOK, DM, G, bx); \
        EpiRes E{(xin_), XB, ssq + (sidx) * MTOK, 0.5f}; pg8::gemm_phase<EpiRes, pg8::StaticOrder, true, true>(lds, g, S, E, wv); } SEAM(k);

    if (IN(0)) for (int rep = 0; rep < NREP(0); ++rep) p0_prologue(*opaque_args(), lds, G, vcu, wv);
    SEAM(0);
    FFN_UP(1, 0, 0)
#define DEFER_CONVERT(k, sets) if (IN(k) && G == 256 && bx >= 128) { convert_jobs(*opaque_args(), lds, (sets), (bx - 128) * 8 + wv, 128 * 8, wv); }
    DEFER_CONVERT(1, 2)
    SEAM(1);
    FFN_DN(2, 0, (const float*)nullptr, 1)
#if PROBE_PHASE == 100
    if (IN(2)) { xcd_barrier((unsigned*)(ws + WS_BAR), bst, wv); pg8::Gemm g{ACT, (const bf16_t*)(ws + WS_WD), MTOK, DM, FF, FF}; pg8::StaticOrder S; S.init(MTOK, DM, G, bx);
        EpiPlain E{(bf16_t*)(ws + WS_BIG + 88 * MiB), 1024}; pg8::gemm_phase<EpiPlain, pg8::StaticOrder, false, true>(lds, g, S, E, wv); }
#endif
    if (IN(3)) for (int rep = 0; rep < NREP(3); ++rep) { pg8::Gemm g{XB, (const bf16_t*)(ws + WS_WIN), MTOK, 2048, DM, DM}; pg8::StaticOrder S; S.init(MTOK, 2048, G, bx);
        EpiMixIn E{(bf16_t*)(ws + WS_APOOL), (bf16_t*)(ws + WS_UC), ssq + 1 * MTOK}; pg8::gemm_phase<EpiMixIn, pg8::StaticOrder, true, true>(lds, g, S, E, wv); }
    SEAM(3);
    if (IN(4)) for (int rep = 0; rep < NREP(4); ++rep) {
        for (int rp = 0; rp < ((PROBE_PHASE == 40) ? 2 : 1); ++rp)
        for (int it = bx; it < 256; it += G) pool_item((const bf16_t*)(ws + WS_APOOL), (bf16_t*)(ws + WS_PP), it, wv);
        for (int blk = bx; blk < 256; blk += G) { __syncthreads(); hyena_block(*opaque_args(), lds, blk, wv); }
    }
    SEAM(4);
    if (IN(5)) for (int rep = 0; rep < NREP(5); ++rep) {
        __syncthreads();
        if (G == 256) { if (bx >= 128) transpose_tiles((const bf16_t*)(ws + WS_YC), (bf16_t*)(ws + WS_Y), lds, 128, bx - 128, wv); }
        else transpose_tiles((const bf16_t*)(ws + WS_YC), (bf16_t*)(ws + WS_Y), lds, G, bx, wv);
        __syncthreads();
        pg8::Gemm g{(const bf16_t*)(ws + WS_PP), (const bf16_t*)(ws + WS_WPOOL), MTOK, 512, 512, 512}; pg8::StaticOrder S; S.init(MTOK, 512, G, bx);
        EpiPlain E{(bf16_t*)(ws + WS_Y), 1024}; pg8::gemm_phase<EpiPlain, pg8::StaticOrder, true, true>(lds, g, S, E, wv);
    }
    SEAM(5);
    if (IN(6)) { pg8::Gemm g{(const bf16_t*)(ws + WS_Y), (const bf16_t*)(ws + WS_WOUT), MTOK, DM, DM, DM}; pg8::StaticOrder S; S.init(MTOK, DM, G, bx);
        EpiRes E{nullptr, XB, ssq + 2 * MTOK, 1.0f}; pg8::gemm_phase<EpiRes, pg8::StaticOrder, true, true>(lds, g, S, E, wv); }
    SEAM(6);
    FFN_UP(7, 1, 2)
    DEFER_CONVERT(7, 4)
    SEAM(7);
    FFN_DN(8, 1, (const float*)nullptr, 3)
    FFN_UP(9, 2, 3)
    DEFER_CONVERT(9, 8)
    SEAM(9);
    FFN_DN(10, 2, (const float*)nullptr, 4)
    if (IN(11)) { pg8::Gemm g{XB, (const bf16_t*)(ws + WS_WD1), MTOK, 512, DM, DM}; pg8::StaticOrder S; S.init(MTOK, 512, G, bx);
        EpiM1 E{(bf16_t*)(ws + WS_A2), (bf16_t*)(ws + WS_KR), ssq + 4 * MTOK, ssq_q}; pg8::gemm_phase<EpiM1, pg8::StaticOrder, true, true>(lds, g, S, E, wv); }
    SEAM(11);
    if (IN(12)) for (int rep = 0; rep < NREP(12); ++rep) {
        { pg8::Gemm g{(const bf16_t*)(ws + WS_A2), (const bf16_t*)(ws + WS_WUP), MTOK, 1536, 256, 384}; pg8::StaticOrder S; S.init(MTOK, 1536, G, bx);
          EpiM2 E{(bf16_t*)(ws + WS_Q), (bf16_t*)(ws + WS_KV), ssq_q, ssq_kv, 0}; pg8::gemm_phase<EpiM2, pg8::StaticOrder, true, true>(lds, g, S, E, wv); }
        { pg8::Gemm g{(const bf16_t*)(ws + WS_A2) + 128, (const bf16_t*)(ws + WS_WUP) + (size_t)1536 * 384 + 128, MTOK, 2048, 256, 384}; pg8::StaticOrder S; S.init(MTOK, 2048, G, bx);
          EpiM2 E{(bf16_t*)(ws + WS_Q), (bf16_t*)(ws + WS_KV), ssq_q, ssq_kv, 6}; pg8::gemm_phase<EpiM2, pg8::StaticOrder, true, true>(lds, g, S, E, wv); } }
    SEAM(12);
    if (IN(13)) for (int rep = 0; rep < NREP(13); ++rep) {
        for (int u = vcu; u < NB * 16 * 16; u += G) { const int bh = u >> 4, qb = u & 15;
            att::attn_unit((const bf16_t*)(ws + WS_Q), (const bf16_t*)(ws + WS_KV), (const bf16_t*)(ws + WS_KR), (bf16_t*)(ws + WS_O), bh >> 4, bh & 15, qb, (char*)lds_raw, wv); }
    }
    SEAM(13);
    if (IN(14)) { pg8::Gemm g{(const bf16_t*)(ws + WS_O), (const bf16_t*)(ws + WS_WO), MTOK, DM, DM, DM}; pg8::StaticOrder S; S.init(MTOK, DM, G, bx);
        EpiRes E{nullptr, XB, ssq + 5 * MTOK, 1.0f}; pg8::gemm_phase<EpiRes, pg8::StaticOrder, true, true>(lds, g, S, E, wv); }
    SEAM(14);
    FFN_UP(15, 3, 5)
    SEAM(15);
    if (IN(16)) {
        if (G == 256) {
            pg8::Gemm g{ACT, (const bf16_t*)(ws + WS_WD) + (size_t)3 * DM * FF, MTOK, DM, FF, FF}; pg8::StaticOrder S; S.init(MTOK, DM, G, bx);
            EpiResFinal E{XB, ssq + 6 * MTOK, (unsigned*)(ws + WS_CNT), opaque_args()->in[I_FNG], X, 0.5f, wv}; pg8::gemm_phase<EpiResFinal, pg8::StaticOrder, true, true>(lds, g, S, E, wv);
        } else {
            pg8::Gemm g{ACT, (const bf16_t*)(ws + WS_WD) + (size_t)3 * DM * FF, MTOK, DM, FF, FF}; pg8::StaticOrder S; S.init(MTOK, DM, G, bx);
            EpiRes E{nullptr, XB, ssq + 6 * MTOK, 0.5f}; pg8::gemm_phase<EpiRes, pg8::StaticOrder, true, true>(lds, g, S, E, wv);
        }
    }
    if (G != 256) SEAM(16);
    if (IN(17) && G != 256) {
        const int lane = tid_opaque(wv) & 63, gw = vcu * 8 + wv; const float* gf = opaque_args()->in[I_FNG];
        for (int m = gw; m < MTOK; m += G * 8) { const float rs = rsqrtf(ssq[6 * MTOK + m] * (1.f / DM) + EPS);
            const u32x2* xr = (const u32x2*)(XB + (size_t)m * DM) + lane; f32x4* orow = (f32x4*)(X + (size_t)m * DM) + lane;
#pragma unroll
            for (int j = 0; j < 4; ++j) { const u32x2 w = xr[64 * j]; const f32x4 gv = ((const f32x4*)gf)[lane + 64 * j];
                const f32x4 xv = {__builtin_bit_cast(float, w.x << 16), __builtin_bit_cast(float, w.x & 0xffff0000u), __builtin_bit_cast(float, w.y << 16), __builtin_bit_cast(float, w.y & 0xffff0000u)};
                orow[64 * j] = xv * rs * gv; } }
    }
#undef IN
#undef SEAM
#undef FFN_UP
#undef FFN_DN
}

extern "C" void kernel_launch(void* const* d_in, const int* in_sizes, int n_in, void* d_out, int out_size, void* d_ws, size_t ws_size, hipStream_t stream) {
    static int grid = 0;
    if (grid == 0) {
        if (n_in != 29 || out_size != MTOK * DM || ws_size < WS_END) { fprintf(stderr, "kernel_launch: unexpected shapes n_in %d out %d ws %zu\n", n_in, out_size, ws_size); grid = -1; return; }
        int dev = 0, cus = 0, per_cu = 0;
        if (hipGetDevice(&dev) != hipSuccess || hipDeviceGetAttribute(&cus, hipDeviceAttributeMultiprocessorCount, dev) != hipSuccess) { grid = -1; return; }
        if (hipFuncSetAttribute((const void*)mega_fwd, hipFuncAttributeMaxDynamicSharedMemorySize, LDS_BYTES) != hipSuccess) { fprintf(stderr, "kernel_launch: hipFuncSetAttribute failed\n"); grid = -1; return; }
        if (hipOccupancyMaxActiveBlocksPerMultiprocessor(&per_cu, (const void*)mega_fwd, 512, LDS_BYTES) != hipSuccess || per_cu < 1) { fprintf(stderr, "kernel_launch: occupancy query says %d\n", per_cu); per_cu = 1; }
        (void)hipGetLastError();
        grid = cus;
    }
    if (grid < 0) return;
    if (hipMemsetAsync((char*)d_ws + WS_BAR, 0, 16384, stream) != hipSuccess) { fprintf(stderr, "kernel_launch: memset failed\n"); return; }
    Args a{};
    for (int i = 0; i < 29; ++i) a.in[i] = (const float*)d_in[i];
    a.out = (float*)d_out; a.ws = (unsigned char*)d_ws; a.ph_lo = 0; a.ph_hi = NPH;
    void* args[] = {&a};
    hipError_t e = hipLaunchCooperativeKernel((const void*)mega_fwd, dim3(grid), dim3(512), args, LDS_BYTES, stream);
    if (e != hipSuccess) fprintf(stderr, "kernel_launch: cooperative launch failed: %s (grid %d)\n", hipGetErrorString(e), grid);
}
```

```cpp
#include <hip/hip_runtime.h>
#include <hip/hip_cooperative_groups.h>
#include <cstdio>
#include <cstdint>
namespace cg = cooperative_groups;

#define LAS __attribute__((address_space(3)))
typedef unsigned short bf16_t;
typedef short bf16x8 __attribute__((ext_vector_type(8)));
typedef short s16x4 __attribute__((ext_vector_type(4)));
typedef float f32x4 __attribute__((ext_vector_type(4)));
typedef float f32x16 __attribute__((ext_vector_type(16)));
typedef unsigned u32x4 __attribute__((ext_vector_type(4)));
typedef unsigned u32x2 __attribute__((ext_vector_type(2)));

__device__ __forceinline__ unsigned cvt_pk_bf16(float lo, float hi) { unsigned r; asm volatile("v_cvt_pk_bf16_f32 %0, %1, %2" : "=v"(r) : "v"(lo), "v"(hi)); return r; }
__device__ __forceinline__ unsigned f2bf(float f) { unsigned u = __builtin_bit_cast(unsigned, f); return (u + 0x7fffu + ((u >> 16) & 1u)) >> 16; }
__device__ __forceinline__ float bf2f(bf16_t b) { return __builtin_bit_cast(float, (unsigned)b << 16); }
__device__ __forceinline__ int tid_opaque(int wv) { int l = __builtin_amdgcn_mbcnt_hi(~0u, __builtin_amdgcn_mbcnt_lo(~0u, 0u)); asm volatile("" : "+v"(l)); return (wv << 6) | l; }
__device__ __forceinline__ float wave_sum(float v) {
    int l = __builtin_amdgcn_mbcnt_hi(~0u, __builtin_amdgcn_mbcnt_lo(~0u, 0u)); asm volatile("" : "+v"(l));
#pragma unroll
    for (int o = 1; o < 64; o <<= 1) v += __builtin_bit_cast(float, __builtin_amdgcn_ds_bpermute((l ^ o) << 2, __builtin_bit_cast(int, v)));
    return v;
}

namespace pg8 {
constexpr int BM = 256, BK = 64, HALF = 128, HTB = HALF * BK * 2, STAGE_BYTES = 8 * HTB, NXCD = 8, WGM = 8;
__host__ __device__ __forceinline__ int lds_byte(int r, int c) { const int st = (r >> 4) * 2 + (c >> 5), rr = r & 15, cc = c & 31, ob = rr * 64 + cc * 2; return st * 1024 + (ob ^ (((ob >> 9) & 1) << 5)); }
__host__ __device__ __forceinline__ void stage_rc(int b, int& R, int& C) { const int st = b / 1024, sb = b % 1024, swz = sb ^ (((sb >> 9) & 1) << 5); R = (st >> 1) * 16 + swz / 64; C = (st & 1) * 32 + (swz % 64) / 2; }
__host__ __device__ __forceinline__ int perm32(int rho) { const int n = rho >> 4, i = rho & 15; return 8 * (i >> 2) + 4 * n + (i & 3); }
struct Unit { int pm, pn; };
struct Gemm { const bf16_t* A; const bf16_t* Bt; int M, N, K, ld; };
struct StaticOrder {
    int nM, nN, nwg, G, c;
    __host__ __device__ void init(int M, int N, int G_, int c_) { nM = M / BM; nN = N / BM; nwg = nM * nN; G = G_; c = c_; }
    __host__ __device__ bool next(int i, Unit& u) const {
        const long L = (long)i * G + c; if (L >= nwg) return false;
        int wgid = (int)L; { const int q = nwg / NXCD, r = nwg % NXCD, xcd = wgid % NXCD, off = wgid / NXCD; wgid = (xcd < r ? xcd * (q + 1) : r * (q + 1) + (xcd - r) * q) + off; }
        const int nig = WGM * nN, gid = wgid / nig, fm = gid * WGM, gsz = (nM - fm) < WGM ? (nM - fm) : WGM;
        u.pm = fm + ((wgid % nig) % gsz); u.pn = (wgid % nig) / gsz; return true;
    }
    __device__ __forceinline__ void a_ready(const Unit&) const {}
    __device__ __forceinline__ void done(const Unit&) const {}
};

template <class Epi, class Sched, bool ALIGN_EPI = false, bool SP2 = false>
__device__ __forceinline__ void gemm_phase(LAS unsigned char* lds, const Gemm g, const Sched& S, const Epi& E, int wv) {
    const int tid = tid_opaque(wv), wid = __builtin_amdgcn_readfirstlane(tid >> 6), lane = tid & 63, wr = wid >> 2, wc = wid & 3, fr = lane & 15, fq = lane >> 4;
    const int K = g.ld, nt = g.K / BK;
    unsigned voffA[2], voffB[2];
#pragma unroll
    for (int i = 0; i < 2; ++i) { int R, C; stage_rc(tid * 16 + i * 8192, R, C); const int Rb = Epi::PERM ? ((R & ~31) + perm32(R & 31)) : R;
        voffA[i] = (unsigned)(R * K + C) * 2u; voffB[i] = (unsigned)(Rb * K + C) * 2u; }
    const size_t kstep = (size_t)(BK * 2);
    const size_t hstep = (size_t)HALF * K * 2;
    const size_t tstep = 2 * hstep;
    const unsigned ldsw = (unsigned)wid * 1024u;
    const int aoff = lds_byte(wr * 64 + fr, fq * 8), boff = lds_byte(wc * 32 + fr, fq * 8);
#define PG8_SA(b, h) (((b) * 2 + (h)) * HTB)
#define PG8_SB(b, h) ((4 + (b) * 2 + (h)) * HTB)
#define PG8_STAGE(bufoff, gbase, voff) do { _Pragma("unroll") for (int _i = 0; _i < 2; ++_i) \
        __builtin_amdgcn_global_load_lds((const unsigned*)((const char*)(gbase) + (voff)[_i]), (LAS unsigned*)(lds + (bufoff) + ldsw + _i * 8192), 16, 0, 0); } while (0)
#define PG8_LDA(dst, b, h) do { _Pragma("unroll") for (int m = 0; m < 4; ++m) _Pragma("unroll") for (int k = 0; k < 2; ++k) dst[m][k] = *(const LAS bf16x8*)(lds + PG8_SA(b, h) + aoff + m * 2048 + k * 1024); } while (0)
#define PG8_LDB(dst, b, h) do { _Pragma("unroll") for (int n = 0; n < 2; ++n) _Pragma("unroll") for (int k = 0; k < 2; ++k) dst[n][k] = *(const LAS bf16x8*)(lds + PG8_SB(b, h) + boff + n * 2048 + k * 1024); } while (0)
#define PG8_MMA(ai, bj, At, Bt) do { __builtin_amdgcn_s_setprio(1); _Pragma("unroll") for (int m = 0; m < 4; ++m) _Pragma("unroll") for (int n = 0; n < 2; ++n) _Pragma("unroll") for (int k = 0; k < 2; ++k) \
        acc[ai][bj][m][n] = __builtin_amdgcn_mfma_f32_16x16x32_bf16(Bt[n][k], At[m][k], acc[ai][bj][m][n], 0, 0, 0); __builtin_amdgcn_s_setprio(0); } while (0)
#define PG8_WAIT_V(n) asm volatile("s_waitcnt vmcnt(" #n ")" ::: "memory")
#define PG8_WAIT_L(n) asm volatile("s_waitcnt lgkmcnt(" #n ")" ::: "memory")
#define PG8_BAR __builtin_amdgcn_s_barrier()
#define PG8_SCHED __builtin_amdgcn_sched_barrier(0)
    Unit cur, nxt; int ui = 0;
    if (!S.next(0, cur)) return;
    f32x4 acc[2][2][4][2];
#pragma unroll
    for (int a = 0; a < 2; ++a)
#pragma unroll
        for (int b = 0; b < 2; ++b)
#pragma unroll
            for (int m = 0; m < 4; ++m)
#pragma unroll
                for (int n = 0; n < 2; ++n) acc[a][b][m][n] = (f32x4){0.f, 0.f, 0.f, 0.f};
    bf16x8 At[4][2], B0[2][2], B1[2][2];
    const char* cA = (const char*)g.A + (size_t)cur.pm * tstep; const char* cB = (const char*)g.Bt + (size_t)cur.pn * tstep;
    S.a_ready(cur);
    if constexpr (SP2) {
        PG8_STAGE(PG8_SB(0, 0), cB, voffB); PG8_STAGE(PG8_SB(0, 1), cB + hstep, voffB); PG8_STAGE(PG8_SA(0, 0), cA, voffA); PG8_STAGE(PG8_SA(0, 1), cA + hstep, voffA);
        if (wr == 1) PG8_BAR;
        PG8_WAIT_V(2); PG8_BAR;
        PG8_STAGE(PG8_SB(1, 0), cB + kstep, voffB); PG8_STAGE(PG8_SA(1, 0), cA + kstep, voffA); PG8_STAGE(PG8_SB(1, 1), cB + hstep + kstep, voffB);
        PG8_WAIT_V(6); PG8_BAR;
    } else {
        PG8_STAGE(PG8_SB(0, 0), cB, voffB); PG8_STAGE(PG8_SA(0, 0), cA, voffA); PG8_STAGE(PG8_SB(0, 1), cB + hstep, voffB); PG8_STAGE(PG8_SA(0, 1), cA + hstep, voffA);
        if (wr == 1) PG8_BAR;
        PG8_WAIT_V(4); PG8_BAR;
        PG8_STAGE(PG8_SB(1, 0), cB + kstep, voffB); PG8_STAGE(PG8_SA(1, 0), cA + kstep, voffA); PG8_STAGE(PG8_SB(1, 1), cB + hstep + kstep, voffB);
        PG8_WAIT_V(6); PG8_BAR;
    }
    for (;;) {
        const bool has_next = S.next(ui + 1, nxt);
        const char* nA = has_next ? (const char*)g.A + (size_t)nxt.pm * tstep : cA; const char* nB = has_next ? (const char*)g.Bt + (size_t)nxt.pn * tstep : cB;
        for (int t = 0; t < nt; t += 2) {
            const bool last = (t == nt - 2);
            const char* a1 = cA + (size_t)(t + 1) * kstep;
            const char* a2 = last ? nA : cA + (size_t)(t + 2) * kstep; const char* b2 = last ? nB : cB + (size_t)(t + 2) * kstep;
            const char* a3 = a2 + kstep; const char* b3 = b2 + kstep;
            if (last && has_next) S.a_ready(nxt);
            if constexpr (SP2) {
            PG8_LDB(B0, 0, 0); PG8_LDB(B1, 0, 1); PG8_SCHED; PG8_LDA(At, 0, 0); PG8_STAGE(PG8_SA(1, 1), a1 + hstep, voffA);
            PG8_WAIT_V(8); PG8_WAIT_L(0); PG8_BAR; PG8_MMA(0, 0, At, B0); PG8_MMA(0, 1, At, B1); PG8_BAR; PG8_SCHED;
            PG8_LDA(At, 0, 1); PG8_STAGE(PG8_SB(0, 0), b2, voffB); PG8_STAGE(PG8_SB(0, 1), b2 + hstep, voffB); PG8_STAGE(PG8_SA(0, 0), a2, voffA);
            PG8_WAIT_V(8); PG8_WAIT_L(0); PG8_BAR; PG8_MMA(1, 0, At, B0); PG8_MMA(1, 1, At, B1); PG8_BAR; PG8_SCHED;
            PG8_LDB(B0, 1, 0); PG8_LDB(B1, 1, 1); PG8_SCHED; PG8_LDA(At, 1, 0); PG8_STAGE(PG8_SA(0, 1), a2 + hstep, voffA);
            PG8_WAIT_V(8); PG8_WAIT_L(0); PG8_BAR; PG8_MMA(0, 0, At, B0); PG8_MMA(0, 1, At, B1); PG8_BAR; PG8_SCHED;
            PG8_LDA(At, 1, 1); PG8_STAGE(PG8_SB(1, 0), b3, voffB); PG8_STAGE(PG8_SB(1, 1), b3 + hstep, voffB); PG8_STAGE(PG8_SA(1, 0), a3, voffA);
            PG8_WAIT_V(8); PG8_WAIT_L(0); PG8_BAR; PG8_MMA(1, 0, At, B0); PG8_MMA(1, 1, At, B1); PG8_BAR; PG8_SCHED;
            } else {
            PG8_LDB(B0, 0, 0); PG8_SCHED; PG8_LDA(At, 0, 0); PG8_STAGE(PG8_SA(1, 1), a1 + hstep, voffA);
            PG8_WAIT_L(8); PG8_BAR; PG8_WAIT_L(0); PG8_MMA(0, 0, At, B0); PG8_BAR; PG8_SCHED;
            PG8_LDB(B1, 0, 1); PG8_STAGE(PG8_SB(0, 0), b2, voffB);
            PG8_BAR; PG8_WAIT_L(0); PG8_MMA(0, 1, At, B1); PG8_BAR;
            PG8_LDA(At, 0, 1); PG8_STAGE(PG8_SA(0, 0), a2, voffA);
            PG8_BAR; PG8_WAIT_L(0); PG8_MMA(1, 0, At, B0); PG8_BAR; PG8_SCHED;
            PG8_STAGE(PG8_SB(0, 1), b2 + hstep, voffB);
            PG8_WAIT_V(6); PG8_BAR; PG8_MMA(1, 1, At, B1); PG8_BAR;
            PG8_LDB(B0, 1, 0); PG8_SCHED; PG8_LDA(At, 1, 0); PG8_STAGE(PG8_SA(0, 1), a2 + hstep, voffA);
            PG8_WAIT_L(8); PG8_BAR; PG8_WAIT_L(0); PG8_MMA(0, 0, At, B0); PG8_BAR; PG8_SCHED;
            PG8_LDB(B1, 1, 1); PG8_STAGE(PG8_SB(1, 0), b3, voffB);
            PG8_BAR; PG8_WAIT_L(0); PG8_MMA(0, 1, At, B1); PG8_BAR;
            PG8_LDA(At, 1, 1); PG8_STAGE(PG8_SA(1, 0), a3, voffA);
            PG8_BAR; PG8_WAIT_L(0); PG8_MMA(1, 0, At, B0); PG8_BAR; PG8_SCHED;
            PG8_STAGE(PG8_SB(1, 1), b3 + hstep, voffB);
            PG8_WAIT_V(6); PG8_BAR; PG8_MMA(1, 1, At, B1); PG8_BAR;
            }
        }
        if constexpr (ALIGN_EPI) { if (wr == 0) PG8_BAR; }
        { int le = __builtin_amdgcn_mbcnt_hi(~0u, __builtin_amdgcn_mbcnt_lo(~0u, 0u)); asm volatile("" : "+v"(le));
          E(acc, cur, wr, wc, le & 15, le >> 4); } S.done(cur);
        if (!has_next) break;
#pragma unroll
        for (int a = 0; a < 2; ++a)
#pragma unroll
            for (int b = 0; b < 2; ++b)
#pragma unroll
                for (int m = 0; m < 4; ++m)
#pragma unroll
                    for (int n = 0; n < 2; ++n) acc[a][b][m][n] = (f32x4){0.f, 0.f, 0.f, 0.f};
        cur = nxt; cA = nA; cB = nB; ++ui;
        if constexpr (ALIGN_EPI) { if (wr == 1) PG8_BAR; }
    }
    PG8_WAIT_V(0);
    if constexpr (!ALIGN_EPI) { if (wr == 0) PG8_BAR; }
    PG8_BAR;
#undef PG8_SA
#undef PG8_SB
#undef PG8_STAGE
#undef PG8_LDA
#undef PG8_LDB
#undef PG8_MMA
#undef PG8_WAIT_V
#undef PG8_WAIT_L
#undef PG8_BAR
#undef PG8_SCHED
}
}

constexpr int NB = 4, SEQ = 4096, DM = 1024, FF = 2816, MTOK = NB * SEQ;
constexpr float EPS = 1e-6f;
constexpr size_t MiB = 1u << 20;
constexpr size_t WS_SSQ = 0;
constexpr size_t WS_SSQQ = 512 * 1024;
constexpr size_t WS_SSQKV = 576 * 1024;
constexpr size_t WS_CNT = 640 * 1024;
constexpr size_t WS_BAR = 768 * 1024;
constexpr size_t WS_HID3 = 1 * MiB;
constexpr size_t WS_KR = 3 * MiB;
constexpr size_t WS_Z1 = 4 * MiB;
constexpr size_t WS_WGU = 20 * MiB;
constexpr size_t WS_WD = 64 * MiB;
constexpr size_t WS_WIN = 86 * MiB;
constexpr size_t WS_WPOOL = 90 * MiB;
constexpr size_t WS_WOUT = 91 * MiB;
constexpr size_t WS_WD1 = 93 * MiB;
constexpr size_t WS_WUP = 94 * MiB;
constexpr size_t WS_WO = 97 * MiB;
constexpr size_t WS_XB = 100 * MiB;
constexpr size_t WS_BIG = 132 * MiB;
constexpr size_t WS_ACT = WS_BIG;
constexpr size_t WS_APOOL = WS_BIG;
constexpr size_t WS_UC = WS_BIG + 16 * MiB;
constexpr size_t WS_PP = WS_BIG + 64 * MiB;
constexpr size_t WS_YC = WS_BIG + 80 * MiB;
constexpr size_t WS_Y = WS_BIG;
constexpr size_t WS_A2 = WS_BIG;
constexpr size_t WS_Q = WS_BIG + 12 * MiB;
constexpr size_t WS_KV = WS_BIG + 60 * MiB;
constexpr size_t WS_O = 20 * MiB;
constexpr size_t WS_END = 256 * MiB;
static_assert(WS_KV + (size_t)MTOK * 2048 * 2 <= WS_END && WS_YC + 16 * MiB <= WS_END && WS_ACT + (size_t)MTOK * FF * 2 <= WS_END, "ws map");
static_assert(WS_SSQKV == WS_SSQQ + (size_t)MTOK * 4, "ssq_kv follows ssq_q");
constexpr int LDS_BYTES = 147456;
constexpr int FFT_BUF = 8704 * 8;

using pg8::Unit;
typedef f32x4 AccT[2][2][4][2];
__device__ __forceinline__ float silu_mul(float g, float u) { return g * __builtin_amdgcn_rcpf(1.f + __expf(-g)) * u; }

struct EpiAct { static constexpr bool PERM = true;
    bf16_t* O; const float* ssq;
    __device__ __forceinline__ void operator()(const AccT& acc, const Unit& u, int wr, int wc, int fr, int fq) const {
        const int row0 = u.pm * 256 + wr * 64 + fr, col0 = u.pn * 128 + wc * 32 + 8 * fq;
        float rsv[8];
#pragma unroll
        for (int i = 0; i < 8; ++i) rsv[i] = ssq[row0 + (i >> 2) * 128 + (i & 3) * 16];
#pragma unroll
        for (int ai = 0; ai < 2; ++ai)
#pragma unroll
            for (int m = 0; m < 4; ++m) { const int row = row0 + ai * 128 + m * 16; const float rs = rsqrtf(rsv[ai * 4 + m] * (1.f / DM) + EPS);
                const float nrl = -1.4426950408889634f * rs, rs2 = rs * rs; f32x4 y[2];
#pragma unroll
                for (int n = 0; n < 2; ++n) { const f32x4 ag = acc[ai][0][m][n], au = acc[ai][1][m][n]; const f32x4 t = ag * nrl;
                    f32x4 d; d[0] = __builtin_amdgcn_exp2f(t[0]); d[1] = __builtin_amdgcn_exp2f(t[1]); d[2] = __builtin_amdgcn_exp2f(t[2]); d[3] = __builtin_amdgcn_exp2f(t[3]);
                    d = d + 1.0f; f32x4 r; r[0] = __builtin_amdgcn_rcpf(d[0]); r[1] = __builtin_amdgcn_rcpf(d[1]); r[2] = __builtin_amdgcn_rcpf(d[2]); r[3] = __builtin_amdgcn_rcpf(d[3]);
                    y[n] = ((ag * au) * rs2) * r; }
                u32x4 w; w.x = cvt_pk_bf16(y[0][0], y[0][1]); w.y = cvt_pk_bf16(y[0][2], y[0][3]); w.z = cvt_pk_bf16(y[1][0], y[1][1]); w.w = cvt_pk_bf16(y[1][2], y[1][3]);
                *(u32x4*)(O + (size_t)row * FF + col0) = w; }
    }
};
struct EpiRes { static constexpr bool PERM = true;
    const float* xin32; bf16_t* xb; float* ssq_next; float alpha;
    __device__ __forceinline__ void operator()(const AccT& acc, const Unit& u, int wr, int wc, int fr, int fq) const {
        const int row0 = u.pm * 256 + wr * 64 + fr, col0 = u.pn * 256 + wc * 32 + 8 * fq;
        u32x4 xr[8][2];
#pragma unroll
        for (int i = 0; i < 8; ++i)
#pragma unroll
            for (int bj = 0; bj < 2; ++bj) xr[i][bj] = *(const u32x4*)(xb + (size_t)(row0 + (i >> 2) * 128 + (i & 3) * 16) * DM + col0 + bj * 128);
#pragma unroll
        for (int ai = 0; ai < 2; ++ai)
#pragma unroll
            for (int m = 0; m < 4; ++m) { const int row = row0 + ai * 128 + m * 16; float sq = 0.f;
#pragma unroll
                for (int bj = 0; bj < 2; ++bj) { const size_t off = (size_t)row * DM + col0 + bj * 128; f32x4 x0, x1;
                    if (xin32) { x0 = *(const f32x4*)(xin32 + off); x1 = *(const f32x4*)(xin32 + off + 4); }
                    else { const u32x4 w = xr[ai * 4 + m][bj];
                        x0 = (f32x4){__builtin_bit_cast(float, w.x << 16), __builtin_bit_cast(float, w.x & 0xffff0000u), __builtin_bit_cast(float, w.y << 16), __builtin_bit_cast(float, w.y & 0xffff0000u)};
                        x1 = (f32x4){__builtin_bit_cast(float, w.z << 16), __builtin_bit_cast(float, w.z & 0xffff0000u), __builtin_bit_cast(float, w.w << 16), __builtin_bit_cast(float, w.w & 0xffff0000u)}; }
                    x0 = x0 + acc[ai][bj][m][0] * alpha; x1 = x1 + acc[ai][bj][m][1] * alpha;
                    sq += ((x0[0] * x0[0] + x0[1] * x0[1]) + (x0[2] * x0[2] + x0[3] * x0[3])) + ((x1[0] * x1[0] + x1[1] * x1[1]) + (x1[2] * x1[2] + x1[3] * x1[3]));
                    u32x4 o; o.x = cvt_pk_bf16(x0[0], x0[1]); o.y = cvt_pk_bf16(x0[2], x0[3]); o.z = cvt_pk_bf16(x1[0], x1[1]); o.w = cvt_pk_bf16(x1[2], x1[3]);
                    *(u32x4*)(xb + off) = o; }
                sq += __shfl_xor(sq, 16); sq += __shfl_xor(sq, 32);
                if (fq == 0) atomicAdd(ssq_next + row, sq); }
    }
};
struct EpiResFinal { static constexpr bool PERM = true;
    const bf16_t* xb; float* ssq; unsigned* cnt; const float* gfin; float* out; float alpha; int wv;
    __device__ __forceinline__ void operator()(AccT& acc, const Unit& u, int wr, int wc, int fr, int fq) const {
        const int row0 = u.pm * 256 + wr * 64 + fr, col0 = u.pn * 256 + wc * 32 + 8 * fq;
        u32x4 xr[8][2];
#pragma unroll
        for (int i = 0; i < 8; ++i)
#pragma unroll
            for (int bj = 0; bj < 2; ++bj) xr[i][bj] = *(const u32x4*)(xb + (size_t)(row0 + (i >> 2) * 128 + (i & 3) * 16) * DM + col0 + bj * 128);
#pragma unroll
        for (int ai = 0; ai < 2; ++ai)
#pragma unroll
            for (int m = 0; m < 4; ++m) { const int row = row0 + ai * 128 + m * 16; float sq = 0.f;
#pragma unroll
                for (int bj = 0; bj < 2; ++bj) { const u32x4 w = xr[ai * 4 + m][bj];
                    f32x4 x0 = (f32x4){__builtin_bit_cast(float, w.x << 16), __builtin_bit_cast(float, w.x & 0xffff0000u), __builtin_bit_cast(float, w.y << 16), __builtin_bit_cast(float, w.y & 0xffff0000u)};
                    f32x4 x1 = (f32x4){__builtin_bit_cast(float, w.z << 16), __builtin_bit_cast(float, w.z & 0xffff0000u), __builtin_bit_cast(float, w.w << 16), __builtin_bit_cast(float, w.w & 0xffff0000u)};
                    x0 = x0 + acc[ai][bj][m][0] * alpha; x1 = x1 + acc[ai][bj][m][1] * alpha; acc[ai][bj][m][0] = x0; acc[ai][bj][m][1] = x1;
                    sq += ((x0[0] * x0[0] + x0[1] * x0[1]) + (x0[2] * x0[2] + x0[3] * x0[3])) + ((x1[0] * x1[0] + x1[1] * x1[1]) + (x1[2] * x1[2] + x1[3] * x1[3])); }
                sq += __shfl_xor(sq, 16); sq += __shfl_xor(sq, 32);
                if (fq == 0) atomicAdd(ssq + row, sq); }
        asm volatile("s_waitcnt vmcnt(0) lgkmcnt(0)" ::: "memory"); __builtin_amdgcn_s_barrier(); asm volatile("" ::: "memory");
        if (wv == 0) {
            if ((fr | fq) == 0) { __threadfence(); __hip_atomic_fetch_add(cnt + u.pm, 1u, __ATOMIC_RELAXED, __HIP_MEMORY_SCOPE_AGENT); }
            unsigned spins = 0;
            while (__hip_atomic_load(cnt + u.pm, __ATOMIC_RELAXED, __HIP_MEMORY_SCOPE_AGENT) < 4u && ++spins < (1u << 22)) __builtin_amdgcn_s_sleep(2);
        }
        asm volatile("s_waitcnt vmcnt(0) lgkmcnt(0)" ::: "memory"); __builtin_amdgcn_s_barrier(); asm volatile("" ::: "memory");
        float tot[8]; f32x4 gv[2][2];
#pragma unroll
        for (int i = 0; i < 8; ++i) tot[i] = __hip_atomic_load(ssq + row0 + (i >> 2) * 128 + (i & 3) * 16, __ATOMIC_RELAXED, __HIP_MEMORY_SCOPE_AGENT);
#pragma unroll
        for (int bj = 0; bj < 2; ++bj) { gv[bj][0] = *(const f32x4*)(gfin + col0 + bj * 128); gv[bj][1] = *(const f32x4*)(gfin + col0 + bj * 128 + 4); }
#pragma unroll
        for (int ai = 0; ai < 2; ++ai)
#pragma unroll
            for (int m = 0; m < 4; ++m) { const int row = row0 + ai * 128 + m * 16; const float rs = rsqrtf(tot[ai * 4 + m] * (1.f / DM) + EPS);
#pragma unroll
                for (int bj = 0; bj < 2; ++bj) { const size_t off = (size_t)row * DM + col0 + bj * 128;
                    *(f32x4*)(out + off) = acc[ai][bj][m][0] * rs * gv[bj][0]; *(f32x4*)(out + off + 4) = acc[ai][bj][m][1] * rs * gv[bj][1]; } }
    }
};
struct EpiMixIn { static constexpr bool PERM = true;
    bf16_t* apool; bf16_t* uc; const float* ssq;
    __device__ __forceinline__ void operator()(const AccT& acc, const Unit& u, int wr, int wc, int fr, int fq) const {
        const int row0 = u.pm * 256 + wr * 64 + fr;
        float rsv[8];
#pragma unroll
        for (int i = 0; i < 8; ++i) rsv[i] = ssq[row0 + (i >> 2) * 128 + (i & 3) * 16];
#pragma unroll
        for (int ai = 0; ai < 2; ++ai)
#pragma unroll
            for (int m = 0; m < 4; ++m) { const int row = row0 + ai * 128 + m * 16; const float rs = rsqrtf(rsv[ai * 4 + m] * (1.f / DM) + EPS);
                if (u.pn < 2) {
#pragma unroll
                    for (int bj = 0; bj < 2; ++bj) { const f32x4 v0 = acc[ai][bj][m][0] * rs, v1 = acc[ai][bj][m][1] * rs;
                        u32x4 w; w.x = cvt_pk_bf16(v0[0], v0[1]); w.y = cvt_pk_bf16(v0[2], v0[3]); w.z = cvt_pk_bf16(v1[0], v1[1]); w.w = cvt_pk_bf16(v1[2], v1[3]);
                        *(u32x4*)(apool + (size_t)row * 512 + u.pn * 256 + bj * 128 + wc * 32 + 8 * fq) = w; }
                } else {
                    const int b = row >> 12, t = row & 4095;
#pragma unroll
                    for (int bj = 0; bj < 2; ++bj)
#pragma unroll
                        for (int n = 0; n < 2; ++n) { const f32x4 v = acc[ai][bj][m][n] * rs; const int ch = (u.pn - 2) * 256 + bj * 128 + wc * 32 + 8 * fq + 4 * n;
                            bf16_t* p = uc + (((size_t)(b * 1536 + ch)) << 12) + t;
                            p[0] = (bf16_t)f2bf(v[0]); p[4096] = (bf16_t)f2bf(v[1]); p[8192] = (bf16_t)f2bf(v[2]); p[12288] = (bf16_t)f2bf(v[3]); }
                } }
    }
};
struct EpiPlain { static constexpr bool PERM = true;
    bf16_t* O; int ldc;
    __device__ __forceinline__ void operator()(const AccT& acc, const Unit& u, int wr, int wc, int fr, int fq) const {
        const int row0 = u.pm * 256 + wr * 64 + fr, col0 = u.pn * 256 + wc * 32 + 8 * fq;
#pragma unroll
        for (int ai = 0; ai < 2; ++ai)
#pragma unroll
            for (int m = 0; m < 4; ++m) { const int row = row0 + ai * 128 + m * 16;
#pragma unroll
                for (int bj = 0; bj < 2; ++bj) { const f32x4 v0 = acc[ai][bj][m][0], v1 = acc[ai][bj][m][1];
                    u32x4 w; w.x = cvt_pk_bf16(v0[0], v0[1]); w.y = cvt_pk_bf16(v0[2], v0[3]); w.z = cvt_pk_bf16(v1[0], v1[1]); w.w = cvt_pk_bf16(v1[2], v1[3]);
                    *(u32x4*)(O + (size_t)row * ldc + col0 + bj * 128) = w; } }
    }
};
__device__ __forceinline__ void sincos_fast(float ang, float& s, float& c) {
    const float hi = 0.15915494f, lo = 6.4206383e-9f;
    const float r = ang * hi, e = fmaf(ang, hi, -r), k = rintf(r);
    const float frac = (r - k) + fmaf(ang, lo, e);
    s = __builtin_amdgcn_sinf(frac); c = __builtin_amdgcn_cosf(frac);
}
__device__ __forceinline__ float rope_inv_freq(int i) { return exp2f(-(float)(2 * i) * (13.287712379549449f / 32.f)); }
struct EpiM1 { static constexpr bool PERM = false;
    bf16_t* a2; bf16_t* kr; const float* ssq; float* ssq_q;
    __device__ __forceinline__ void operator()(const AccT& acc, const Unit& u, int wr, int wc, int fr, int fq) const {
        const int row0 = u.pm * 256 + wr * 64 + fr;
        float rsv[8];
#pragma unroll
        for (int i = 0; i < 8; ++i) rsv[i] = ssq[row0 + (i >> 2) * 128 + (i & 3) * 16];
#pragma unroll
        for (int ai = 0; ai < 2; ++ai)
#pragma unroll
            for (int m = 0; m < 4; ++m) { const int row = row0 + ai * 128 + m * 16; const float rs = rsqrtf(rsv[ai * 4 + m] * (1.f / DM) + EPS); float sq = 0.f;
                const int nbj = (u.pn == 0) ? 2 : 1;
#pragma unroll
                for (int bj = 0; bj < 2; ++bj) if (bj < nbj)
#pragma unroll
                    for (int n = 0; n < 2; ++n) { const f32x4 v = acc[ai][bj][m][n] * rs; sq += (v[0] * v[0] + v[1] * v[1]) + (v[2] * v[2] + v[3] * v[3]);
                        u32x2 w; w.x = cvt_pk_bf16(v[0], v[1]); w.y = cvt_pk_bf16(v[2], v[3]);
                        *(u32x2*)(a2 + (size_t)row * 384 + u.pn * 256 + bj * 128 + wc * 32 + n * 16 + 4 * fq) = w; }
                sq += __shfl_xor(sq, 16); sq += __shfl_xor(sq, 32);
                if (fq == 0) atomicAdd(ssq_q + (size_t)u.pn * MTOK + row, sq);
                if (u.pn == 1 && wc == 0) { const f32x4 x1 = acc[ai][1][m][0] * rs, x2 = acc[ai][1][m][1] * rs; const float pos = (float)(row & 4095);
                    float o1[4], o2[4];
#pragma unroll
                    for (int j = 0; j < 4; ++j) { const float ang = pos * rope_inv_freq(4 * fq + j); float c, s; sincos_fast(ang, s, c); o1[j] = x1[j] * c - x2[j] * s; o2[j] = x1[j] * s + x2[j] * c; }
                    u32x2 w1, w2; w1.x = cvt_pk_bf16(o1[0], o1[1]); w1.y = cvt_pk_bf16(o1[2], o1[3]); w2.x = cvt_pk_bf16(o2[0], o2[1]); w2.y = cvt_pk_bf16(o2[2], o2[3]);
                    *(u32x2*)(kr + (size_t)row * 32 + 4 * fq) = w1; *(u32x2*)(kr + (size_t)row * 32 + 16 + 4 * fq) = w2; }
                __builtin_amdgcn_sched_barrier(0); }
    }
};
struct EpiM2 { static constexpr bool PERM = false;
    bf16_t* q; bf16_t* kv; const float* ssq_q; const float* ssq_kv; int pn0;
    __device__ __forceinline__ void operator()(const AccT& acc, const Unit& u, int wr, int wc, int fr, int fq) const {
        asm volatile("" : "+v"(fr), "+v"(fq));
        const int upn = u.pn + pn0; const int row0 = u.pm * 256 + wr * 64 + fr; const bool isq = upn < 6;
        float rsv[8]; { const float* sp = isq ? ssq_q : ssq_q + MTOK;
#pragma unroll
          for (int i = 0; i < 8; ++i) rsv[i] = sp[row0 + (i >> 2) * 128 + (i & 3) * 16]; }
#pragma unroll
        for (int ai = 0; ai < 2; ++ai)
#pragma unroll
            for (int m = 0; m < 4; ++m) { const int row = row0 + ai * 128 + m * 16;
                const float rs = isq ? rsqrtf(rsv[ai * 4 + m] * (1.f / 256.f) + EPS) * 0.14724445f   : rsqrtf(rsv[ai * 4 + m] * (1.f / 128.f) + EPS);
                const float pos = (float)(row & 4095);
#pragma unroll
                for (int bj = 0; bj < 2; ++bj) { f32x4 v0 = acc[ai][bj][m][0] * rs, v1 = acc[ai][bj][m][1] * rs;
                    const int G = upn * 8 + bj * 4 + wc;
                    if (isq && (G % 3) == 2) {
#pragma unroll
                        for (int j = 0; j < 4; ++j) { const float ang = pos * rope_inv_freq(4 * fq + j); float c, s; sincos_fast(ang, s, c); const float a = v0[j], b = v1[j]; v0[j] = a * c - b * s; v1[j] = a * s + b * c; }
                    }
                    u32x2 w0, w1; w0.x = cvt_pk_bf16(v0[0], v0[1]); w0.y = cvt_pk_bf16(v0[2], v0[3]); w1.x = cvt_pk_bf16(v1[0], v1[1]); w1.y = cvt_pk_bf16(v1[2], v1[3]);
                    bf16_t* p = isq ? q + (size_t)row * 1536 + upn * 256 + bj * 128 + wc * 32 + 4 * fq : kv + (size_t)row * 2048 + (upn - 6) * 256 + bj * 128 + wc * 32 + 4 * fq;
                    *(u32x2*)p = w0; *(u32x2*)(p + 16) = w1; }
                __builtin_amdgcn_sched_barrier(0); }
    }
};

namespace att {
constexpr int NW = 8, QBLK = 32, KVBLK = 64;
constexpr float SCALE = 0.10206207261596575f;
constexpr float THR = 8.f;
constexpr int SHM_V = KVBLK * 64 * 2, SHM_K = KVBLK * 256;
#define KSWZ(row, colB) ((row) * 256 + ((colB) ^ (((row) & 7) << 4)))
#define SBAR() __builtin_amdgcn_sched_barrier(0)
__device__ __forceinline__ int crow(int r, int hi) { return (r & 3) + 8 * (r >> 2) + 4 * hi; }
constexpr float THR2 = THR * 1.4426950408889634f;
__device__ __forceinline__ void partialSM(f32x16& p0, f32x16& p1, float& m_ref, f32x16& negm, float& alpha, bool first) {
  float pmax = p0[0];
#pragma unroll
  for (int r = 1; r < 16; ++r) pmax = fmaxf(pmax, p0[r]);
#pragma unroll
  for (int r = 0; r < 16; ++r) pmax = fmaxf(pmax, p1[r]);
  { auto rr = __builtin_amdgcn_permlane32_swap(__float_as_uint(pmax), __float_as_uint(pmax), false, false);
    pmax = fmaxf(__uint_as_float(rr[0]), __uint_as_float(rr[1])); }
  if (__builtin_expect(!first && __all(pmax <= THR2), 1)) { alpha = 1.f; }
  else { const float dl = first ? pmax : fmaxf(pmax, 0.f); m_ref += dl; alpha = __builtin_amdgcn_exp2f(-dl);
#pragma unroll
    for (int r = 0; r < 16; ++r) { p0[r] -= dl; p1[r] -= dl; }
#pragma unroll
    for (int r = 0; r < 16; ++r) negm[r] = -m_ref; }
#pragma unroll
  for (int r = 0; r < 16; ++r) p0[r] = __builtin_amdgcn_exp2f(p0[r]);
}
__device__ __forceinline__ void finishSM(f32x16& p0, f32x16& p1, float alpha, float& l_reg, bf16x8& pa0, bf16x8& pa1, bf16x8& pa2, bf16x8& pa3) {
#pragma unroll
  for (int r = 0; r < 16; ++r) p1[r] = __builtin_amdgcn_exp2f(p1[r]);
  float ps = 0;
#pragma unroll
  for (int r = 0; r < 16; ++r) ps += p0[r];
#pragma unroll
  for (int r = 0; r < 16; ++r) ps += p1[r];
  { auto rr = __builtin_amdgcn_permlane32_swap(__float_as_uint(ps), __float_as_uint(ps), false, false);
    ps = __uint_as_float(rr[0]) + __uint_as_float(rr[1]); }
  l_reg = l_reg * alpha + ps;
#define PK4(P, BASE, OUT) do { u32x4 w = {cvt_pk_bf16(P[BASE + 0], P[BASE + 1]), cvt_pk_bf16(P[BASE + 2], P[BASE + 3]), \
    cvt_pk_bf16(P[BASE + 4], P[BASE + 5]), cvt_pk_bf16(P[BASE + 6], P[BASE + 7])}; OUT = *reinterpret_cast<bf16x8*>(&w); } while (0)
  PK4(p0, 0, pa0); PK4(p0, 8, pa1); PK4(p1, 0, pa2); PK4(p1, 8, pa3);
#undef PK4
}
__device__ __forceinline__ void qkt(f32x16& p0, f32x16& p1, const char* Ks, const bf16x8* qr, const f32x16& negm, int r32, int hi) {
  p0 = negm; p1 = negm;
#pragma unroll
  for (int d0 = 0; d0 < 6; ++d0) { int cb = (d0 * 16 + hi * 8) * 2;
    bf16x8 b0 = *reinterpret_cast<const bf16x8*>(Ks + KSWZ(r32, cb));
    bf16x8 b1 = *reinterpret_cast<const bf16x8*>(Ks + KSWZ(32 + r32, cb));
    p0 = __builtin_amdgcn_mfma_f32_32x32x16_bf16(b0, qr[d0], p0, 0, 0, 0);
    p1 = __builtin_amdgcn_mfma_f32_32x32x16_bf16(b1, qr[d0], p1, 0, 0, 0); }
}
__device__ __forceinline__ int v_st(int k, int c) { const int kk = k; return ((kk >> 3) * 2 + (c >> 5)) * 512 + ((kk & 7) * 32 + (c & 31)) * 2; }
__device__ __forceinline__ int v_rd_base(int lane) { return ((lane & 3) << 3) | (((lane >> 2) & 3) << 6) | (((lane >> 4) & 1) << 5) | (((lane >> 5) & 1) << 8); }
constexpr int v_rd_off(int d0, int ks, int half) { return d0 * 512 + ks * 2048 + half * 1024; }
template <int OFF> __device__ __forceinline__ s16x4 tr_read(int vb) {
  s16x4 r; asm volatile("ds_read_b64_tr_b16 %0, %1 offset:%2" : "=&v"(r) : "v"(vb), "i"(OFF) : "memory"); return r;
}
template <int D0> __device__ __forceinline__ void pv_one(f32x16& od, int vb, bf16x8 pa0, bf16x8 pa1, bf16x8 pa2, bf16x8 pa3) {
  const s16x4 l0 = tr_read<v_rd_off(D0, 0, 0)>(vb), h0 = tr_read<v_rd_off(D0, 0, 1)>(vb), l1 = tr_read<v_rd_off(D0, 1, 0)>(vb), h1 = tr_read<v_rd_off(D0, 1, 1)>(vb);
  const s16x4 l2 = tr_read<v_rd_off(D0, 2, 0)>(vb), h2 = tr_read<v_rd_off(D0, 2, 1)>(vb), l3 = tr_read<v_rd_off(D0, 3, 0)>(vb), h3 = tr_read<v_rd_off(D0, 3, 1)>(vb);
  asm volatile("s_waitcnt lgkmcnt(0)" ::: "memory"); SBAR();
#define PK(L, H) (bf16x8){L[0], L[1], L[2], L[3], H[0], H[1], H[2], H[3]}
  od = __builtin_amdgcn_mfma_f32_32x32x16_bf16(pa0, PK(l0, h0), od, 0, 0, 0);
  od = __builtin_amdgcn_mfma_f32_32x32x16_bf16(pa1, PK(l1, h1), od, 0, 0, 0);
  od = __builtin_amdgcn_mfma_f32_32x32x16_bf16(pa2, PK(l2, h2), od, 0, 0, 0);
  od = __builtin_amdgcn_mfma_f32_32x32x16_bf16(pa3, PK(l3, h3), od, 0, 0, 0);
#undef PK
}
__device__ __forceinline__ void pv_d0(f32x16* o, int vb, bf16x8 pa0, bf16x8 pa1, bf16x8 pa2, bf16x8 pa3) {
  pv_one<0>(o[0], vb, pa0, pa1, pa2, pa3); pv_one<1>(o[1], vb, pa0, pa1, pa2, pa3);
}
__device__ __forceinline__ void attn_unit(const bf16_t* __restrict__ Q, const bf16_t* __restrict__ KV, const bf16_t* __restrict__ KR, bf16_t* __restrict__ O, int b, int h, int qb, char* lds, int wv) {
  const int tid = tid_opaque(wv), wid = tid >> 6, lane = tid & 63, r32 = lane & 31, hi = lane >> 5;
  char* V_lds = lds; char* K_lds = lds + 2 * SHM_V;
  float* ws = (float*)(lds + 2 * SHM_V + 2 * SHM_K) + wid * 64; float* li_l = ws; float* al_l = ws + 32;
  float m_reg = 0.f, l_reg = 0; f32x16 o[2] = {}; bf16x8 qr[6]; f32x16 negm = {};
  const size_t rowbase = (size_t)b * SEQ;
  const bf16_t* Qw = Q + (rowbase + (size_t)qb * 256 + wid * QBLK + r32) * 1536 + h * 96 + hi * 8;
#pragma unroll
  for (int d0 = 0; d0 < 6; ++d0) qr[d0] = *reinterpret_cast<const bf16x8*>(Qw + d0 * 16);
  const int vr = tid >> 3, vc = (tid & 7) * 8, vst = v_st(vr, vc);
  const bf16_t* vsrc = KV + (rowbase + vr) * 2048 + h * 128 + 64 + vc;
  const int kc0 = tid & 15, kc = kc0 < 12 ? kc0 : kc0 - 4, sr = tid >> 4;
  const bf16_t* ksrc; size_t kstride;
  if (kc < 8) { ksrc = KV + (rowbase + sr) * 2048 + h * 128 + kc * 8; kstride = 2048; } else { ksrc = KR + (rowbase + sr) * 32 + (kc - 8) * 8; kstride = 32; }
  const int kst0 = KSWZ(sr, kc * 16), kst1 = KSWZ(32 + sr, kc * 16);
  const int vb0 = (int)(uintptr_t)V_lds + v_rd_base(lane);
  struct { bf16x8 vs, ks0, ks1; } sr_[2];
#define SLOAD(i, k0) do { sr_[i].vs = *reinterpret_cast<const bf16x8*>(vsrc + (size_t)(k0) * 2048); \
    sr_[i].ks0 = *reinterpret_cast<const bf16x8*>(ksrc + (size_t)(k0) * kstride); sr_[i].ks1 = *reinterpret_cast<const bf16x8*>(ksrc + (size_t)((k0) + 32) * kstride); } while (0)
#define SWRITE(bb, i) do { *(bf16x8*)(V_lds + (bb) * SHM_V + vst) = sr_[i].vs; \
    *(bf16x8*)(K_lds + (bb) * SHM_K + kst0) = sr_[i].ks0; *(bf16x8*)(K_lds + (bb) * SHM_K + kst1) = sr_[i].ks1; } while (0)
#define SWAIT() asm volatile("s_waitcnt vmcnt(3)" ::: "memory")
#define RESC(a) do { if (__any((a) < 1.f)) { if (hi == 0) al_l[r32] = (a); asm volatile("s_waitcnt lgkmcnt(0)" ::: "memory"); \
    _Pragma("unroll") for (int d = 0; d < 2; ++d) _Pragma("unroll") for (int r = 0; r < 16; ++r) o[d][r] *= al_l[crow(r, hi)]; } } while (0)
  f32x16 pA0, pA1, pB0, pB1; float alA, alB; bf16x8 pa0, pa1, pa2, pa3; const int NT = SEQ / KVBLK;
  constexpr int SE = 0, SO = 1;
  SLOAD(SE, 0); SLOAD(SO, KVBLK);
  SWAIT(); SWRITE(0, SE); __syncthreads();
  qkt(pA0, pA1, K_lds, qr, negm, r32, hi); partialSM(pA0, pA1, m_reg, negm, alA, true);
  SLOAD(SE, 2 * KVBLK);
  SWAIT(); SWRITE(1, SO); __syncthreads();
  for (int j = 1; j + 1 < NT; j += 2) {
    SBAR(); qkt(pB0, pB1, K_lds + SHM_K, qr, negm, r32, hi);
    finishSM(pA0, pA1, alA, l_reg, pa0, pa1, pa2, pa3); SBAR();
    SLOAD(SO, (j + 2) * KVBLK); SBAR();
    pv_d0(o, vb0, pa0, pa1, pa2, pa3); partialSM(pB0, pB1, m_reg, negm, alB, false);
    __syncthreads(); SWAIT(); SWRITE(0, SE);
    RESC(alB); __syncthreads();
    SBAR(); qkt(pA0, pA1, K_lds, qr, negm, r32, hi);
    finishSM(pB0, pB1, alB, l_reg, pa0, pa1, pa2, pa3); SBAR();
    if (j + 3 < NT) SLOAD(SE, (j + 3) * KVBLK); SBAR();
    pv_d0(o, vb0 + SHM_V, pa0, pa1, pa2, pa3); partialSM(pA0, pA1, m_reg, negm, alA, false);
    __syncthreads(); SWAIT(); SWRITE(1, SO);
    RESC(alA); __syncthreads();
  }
  SBAR(); qkt(pB0, pB1, K_lds + SHM_K, qr, negm, r32, hi);
  finishSM(pA0, pA1, alA, l_reg, pa0, pa1, pa2, pa3); SBAR();
  pv_d0(o, vb0, pa0, pa1, pa2, pa3); partialSM(pB0, pB1, m_reg, negm, alB, false);
  __syncthreads(); RESC(alB);
  finishSM(pB0, pB1, alB, l_reg, pa0, pa1, pa2, pa3); SBAR();
  pv_d0(o, vb0 + SHM_V, pa0, pa1, pa2, pa3);
  if (hi == 0) li_l[r32] = l_reg; asm volatile("s_waitcnt lgkmcnt(0)" ::: "memory");
  float rli[16];
#pragma unroll
  for (int r = 0; r < 16; ++r) rli[r] = __builtin_amdgcn_rcpf(li_l[crow(r, hi)]);
  bf16_t* Ow = O + (rowbase + (size_t)qb * 256 + wid * QBLK) * 1024 + h * 64;
#pragma unroll
  for (int r = 0; r < 16; ++r) { int orow = crow(r, hi);
#pragma unroll
    for (int d0 = 0; d0 < 2; ++d0) Ow[(size_t)orow * 1024 + d0 * 32 + r32] = (bf16_t)f2bf(o[d0][r] * rli[r]); }
  __syncthreads();
#undef SLOAD
#undef SWRITE
#undef SWAIT
#undef RESC
}
#undef SBAR
}

struct Args { const float* in[29]; float* out; unsigned char* ws; int ph_lo, ph_hi; };
typedef const __attribute__((address_space(4))) Args CArgs;
__device__ __forceinline__ CArgs* opaque_args() { auto p = __builtin_amdgcn_kernarg_segment_ptr(); asm volatile("" : "+s"(p)); return (CArgs*)p; }
enum { I_X = 0, I_NORMG, I_WG, I_WU, I_WDN, I_WIN, I_POOLW, I_POOLS, I_CONVW, I_CONVB, I_HW1, I_HB1, I_HW2, I_HB2, I_HW3, I_HB3, I_SINF, I_HWOUT, I_DECAY, I_HBIAS,
       I_WOUT, I_WDQ, I_QNG, I_WUQ, I_WDKV, I_KVNG, I_WUKV, I_WO, I_FNG };

__device__ __forceinline__ void p0_transpose_item(const float* W, int ldw, const float* gk, bf16_t* WT, int ldk, int koff, int rmode, int roff, LAS float* scr, int kb, int nb, int lane) {
    const int k0 = 64 * kb, n0 = 32 * nb;
    { const int ksub = lane >> 3, nq = lane & 7; f32x4 v[8]; float gg[8];
#pragma unroll
      for (int i = 0; i < 8; ++i) { const int kk = 8 * i + ksub; v[i] = *(const f32x4*)(W + (size_t)(k0 + kk) * ldw + n0 + 4 * nq); gg[i] = gk ? gk[k0 + kk] : 1.f; }
#pragma unroll
      for (int i = 0; i < 8; ++i) { const int kk = 8 * i + ksub; LAS float* d = scr + kk * 33 + 4 * nq; d[0] = v[i][0] * gg[i]; d[1] = v[i][1] * gg[i]; d[2] = v[i][2] * gg[i]; d[3] = v[i][3] * gg[i]; } }
    asm volatile("s_waitcnt lgkmcnt(0)" ::: "memory");
    const int c = lane & 7;
#pragma unroll
    for (int j = 0; j < 4; ++j) { const int n = (lane >> 3) + 8 * j; const LAS float* s = scr + (8 * c) * 33 + n;
        u32x4 o; o.x = cvt_pk_bf16(s[0 * 33], s[1 * 33]); o.y = cvt_pk_bf16(s[2 * 33], s[3 * 33]); o.z = cvt_pk_bf16(s[4 * 33], s[5 * 33]); o.w = cvt_pk_bf16(s[6 * 33], s[7 * 33]);
        const int ng = n0 + n; const int drow = rmode ? ((ng >> 7) * 256 + (ng & 127) + roff) : (ng + roff);
        *(u32x4*)(WT + (size_t)drow * ldk + koff + k0 + 8 * c) = o; }
    asm volatile("s_waitcnt lgkmcnt(0)" ::: "memory");
}

__device__ __forceinline__ void convert_jobs(CArgs& a, LAS unsigned char* lds, int sets, int gw, int NGW, int wv) {
    const int tid = tid_opaque(wv), lane = tid & 63, wave = tid >> 6;
    unsigned char* ws = a.ws;
    LAS float* scr = (LAS float*)(lds + wave * 16384);
    constexpr int IT_GU = 16 * 88, IT_DN = 44 * 32;
    constexpr int NITEMS = 4 * (2 * IT_GU + IT_DN) + 16 * 64 + 16 * 32 + 16 * 8 + 16 * 5 + 4 * 48 + 2 * 64 + 16 * 32;
    for (int it = gw; it < NITEMS; it += NGW) {
        int r = it; const float* W = nullptr; int ldw = 0, nblk = 1; const float* gk = nullptr; bf16_t* WT = nullptr; int ldk = 0, koff = 0, rmode = 0, roff = 0; bool found = false;
#define JOB(on_, ni_, W_, ldw_, gk_, WT_, ldk_, koff_, rmode_, roff_) if (!found && (on_)) { if (r < (ni_)) { W = (W_); ldw = (ldw_); nblk = (ldw_) / 32; gk = (gk_); WT = (WT_); ldk = (ldk_); koff = (koff_); rmode = (rmode_); roff = (roff_); found = true; } else r -= (ni_); }
#pragma unroll
        for (int f = 0; f < 4; ++f) { const float* g = a.in[I_NORMG] + ((f >> 1) * 3 + ((f & 1) ? 2 : 0)) * DM; const bool on = (sets >> f) & 1;
            JOB(on, IT_GU, a.in[I_WG] + (size_t)f * DM * FF, FF, g, (bf16_t*)(ws + WS_WGU) + (size_t)f * 5632 * DM, DM, 0, 1, 0)
            JOB(on, IT_GU, a.in[I_WU] + (size_t)f * DM * FF, FF, g, (bf16_t*)(ws + WS_WGU) + (size_t)f * 5632 * DM, DM, 0, 1, 128)
            JOB(on, IT_DN, a.in[I_WDN] + (size_t)f * DM * FF, DM, nullptr, (bf16_t*)(ws + WS_WD) + (size_t)f * DM * FF, FF, 0, 0, 0) }
        JOB(sets & 1, 16 * 64, a.in[I_WIN], 2048, a.in[I_NORMG] + 1 * DM, (bf16_t*)(ws + WS_WIN), DM, 0, 0, 0)
        JOB(sets & 1, 16 * 32, a.in[I_WOUT], DM, nullptr, (bf16_t*)(ws + WS_WOUT), DM, 0, 0, 0)
        JOB(sets & 4, 16 * 8, a.in[I_WDQ], 256, a.in[I_NORMG] + 4 * DM, (bf16_t*)(ws + WS_WD1), DM, 0, 0, 0)
        JOB(sets & 4, 16 * 5, a.in[I_WDKV], 160, a.in[I_NORMG] + 4 * DM, (bf16_t*)(ws + WS_WD1), DM, 0, 0, 256)
        JOB(sets & 4, 4 * 48, a.in[I_WUQ], 1536, a.in[I_QNG], (bf16_t*)(ws + WS_WUP), 384, 0, 0, 0)
        JOB(sets & 4, 2 * 64, a.in[I_WUKV], 2048, a.in[I_KVNG], (bf16_t*)(ws + WS_WUP), 384, 256, 0, 1536)
        JOB(sets & 4, 16 * 32, a.in[I_WO], DM, nullptr, (bf16_t*)(ws + WS_WO), DM, 0, 0, 0)
#undef JOB
        if (!found) break;
        p0_transpose_item(W, ldw, gk, WT, ldk, koff, rmode, roff, scr, r / nblk, r % nblk, lane);
    }
}
__device__ __forceinline__ void p0_prologue(CArgs& a, LAS unsigned char* lds, int G, int vcu, int wv) {
    const int tid = tid_opaque(wv), lane = tid & 63, wave = tid >> 6;
    unsigned char* ws = a.ws;
    const int gw = vcu * 8 + wave, NGW = G * 8;
    convert_jobs(a, lds, (G == 256) ? 1 : 15, gw, NGW, wv);
    const int gt = vcu * 512 + tid, GT = G * 512;
    { bf16_t* wd1 = (bf16_t*)(ws + WS_WD1) + 416 * DM; for (int i = gt; i < 96 * DM / 8; i += GT) ((u32x4*)wd1)[i] = (u32x4){0u, 0u, 0u, 0u};
      bf16_t* wup = (bf16_t*)(ws + WS_WUP);
      for (int i = gt; i < 1536 * 16; i += GT) { const int rr = i >> 4, c8 = i & 15; *(u32x4*)(wup + (size_t)rr * 384 + 256 + c8 * 8) = (u32x4){0u, 0u, 0u, 0u}; }
      for (int i = gt; i < 2048 * 32; i += GT) { const int rr = 1536 + (i >> 5), c8 = i & 31; *(u32x4*)(wup + (size_t)rr * 384 + c8 * 8) = (u32x4){0u, 0u, 0u, 0u}; } }
    { bf16_t* wp = (bf16_t*)(ws + WS_WPOOL); const float* pw = a.in[I_POOLW]; const float* ps = a.in[I_POOLS];
      for (int i = gt; i < 512 * 512; i += GT) { const int n = i >> 9, k = i & 511, g = n >> 7; float v = 0.f; if ((k >> 7) == g) v = pw[((size_t)g * 128 + (k & 127)) * 128 + (n & 127)] * ps[n]; wp[i] = (bf16_t)f2bf(v); } }
    { float* z = (float*)(ws + WS_SSQ) + MTOK; for (int i = gt; i < 7 * MTOK; i += GT) z[i] = 0.f;
      float* z2 = (float*)(ws + WS_SSQQ); for (int i = gt; i < 2 * MTOK; i += GT) z2[i] = 0.f;
      unsigned* pc = (unsigned*)(ws + WS_CNT); for (int i = gt; i < 64; i += GT) pc[i] = 0u; }
    { const float* x = a.in[I_X]; bf16_t* xb = (bf16_t*)(ws + WS_XB); float* ssq0 = (float*)(ws + WS_SSQ);
      for (int m0 = gw; m0 < MTOK; m0 += 4 * NGW) {
          f32x4 v[4][4];
#pragma unroll
          for (int r = 0; r < 4; ++r) { const int m = (m0 + r * NGW < MTOK) ? m0 + r * NGW : m0; const f32x4* xr = (const f32x4*)(x + (size_t)m * DM) + lane;
#pragma unroll
              for (int j = 0; j < 4; ++j) v[r][j] = xr[64 * j]; }
#pragma unroll
          for (int r = 0; r < 4; ++r) { const int m = m0 + r * NGW; if (m < MTOK) { float s = 0.f;
              unsigned long long* o8 = (unsigned long long*)(xb + (size_t)m * DM) + lane;
#pragma unroll
              for (int j = 0; j < 4; ++j) { const f32x4 q = v[r][j]; s += (q[0] * q[0] + q[1] * q[1]) + (q[2] * q[2] + q[3] * q[3]);
                  o8[64 * j] = (unsigned long long)cvt_pk_bf16(q[0], q[1]) | ((unsigned long long)cvt_pk_bf16(q[2], q[3]) << 32); }
              s = wave_sum(s); if (lane == 0) ssq0[m] = s; } } } }

    { float* hid3 = (float*)(ws + WS_HID3); const float* w1 = a.in[I_HW1]; const float* w2 = a.in[I_HW2]; const float* w3 = a.in[I_HW3]; const float* sf = a.in[I_SINF];
      const float b1 = a.in[I_HB1][lane], b2 = a.in[I_HB2][lane], b3 = a.in[I_HB3][lane], s1 = sf[lane], s2 = sf[64 + lane], s3 = sf[128 + lane];
      float w1r[33], w2r[64], w3r[64];
#pragma unroll
      for (int i = 0; i < 33; ++i) w1r[i] = w1[i * 64 + lane];
#pragma unroll
      for (int i = 0; i < 64; ++i) { w2r[i] = w2[i * 64 + lane]; w3r[i] = w3[i * 64 + lane]; }
      for (int t = gw; t < SEQ; t += NGW) {
          float z = 0.f;
          if (lane == 0) z = (float)t * (1.f / (float)(SEQ - 1));
          else if (lane < 33) { const int bnd = (lane - 1) & 15; const float wt = (6.283185307179586f * (float)t) / (float)SEQ; const float f = 1e-4f + (float)bnd * ((15.f - 1e-4f) / 15.f); const float ph = wt * f;
              z = (lane < 17) ? cosf(ph) : -sinf(ph); }
          float acc1 = b1;
#pragma unroll
          for (int i = 0; i < 33; ++i) acc1 += __builtin_bit_cast(float, __builtin_amdgcn_readlane(__builtin_bit_cast(int, z), i)) * w1r[i];
          const float h1 = sinf(s1 * acc1);
          float acc2 = b2;
#pragma unroll
          for (int i = 0; i < 64; ++i) acc2 += __builtin_bit_cast(float, __builtin_amdgcn_readlane(__builtin_bit_cast(int, h1), i)) * w2r[i];
          const float h2 = sinf(s2 * acc2);
          float acc3 = b3;
#pragma unroll
          for (int i = 0; i < 64; ++i) acc3 += __builtin_bit_cast(float, __builtin_amdgcn_readlane(__builtin_bit_cast(int, h2), i)) * w3r[i];
          hid3[(size_t)t * 64 + lane] = sinf(s3 * acc3);
      } }
}

template <int HW> __device__ __forceinline__ void pool_chunk(const bf16_t* a, bf16_t* out, int t0) {
    float v[64 + 2 * HW];
#pragma unroll
    for (int i = 0; i < 64 + 2 * HW; ++i) { const int s = t0 - HW + i; const int sc = s < 0 ? 0 : (s > SEQ - 1 ? SEQ - 1 : s); const float x = bf2f(a[(size_t)sc * 512]); v[i] = (s == sc) ? x : 0.f; }
    float S = 0.f;
#pragma unroll
    for (int i = 0; i < 2 * HW; ++i) S += v[i];
#pragma unroll
    for (int j = 0; j < 64; ++j) { const int t = t0 + j; const int lo = (t - HW) > 0 ? (t - HW) : 0, hi = (t + HW) < SEQ ? (t + HW) : SEQ;
        out[(size_t)t * 512] = (bf16_t)f2bf(S * __builtin_amdgcn_rcpf((float)(hi - lo)) - v[HW + j]);
        S += v[j + 2 * HW] - v[j]; }
}
__device__ __forceinline__ void pool_item(const bf16_t* apool, bf16_t* pp, int item, int wv) {
    const int c = tid_opaque(wv), g = wv >> 1;
    const int b = item >> 6, t0 = (item & 63) * 64;
    const bf16_t* a = apool + (size_t)b * SEQ * 512 + c; bf16_t* o = pp + (size_t)b * SEQ * 512 + c;
    if (g == 0) pool_chunk<1>(a, o, t0); else if (g == 1) pool_chunk<2>(a, o, t0); else if (g == 2) pool_chunk<4>(a, o, t0); else pool_chunk<8>(a, o, t0);
}

#define HD __device__ __forceinline__
#define LDSP LAS
#ifdef __HIPCC__
typedef float cf __attribute__((ext_vector_type(2)));
#else
#ifndef CF_HOST_DEFINED
#define CF_HOST_DEFINED
struct cf { float x, y; };
#endif
#endif
#ifdef __HIPCC__
HD cf cmul(cf a, cf b) { cf t, r;
    asm("v_pk_mul_f32 %0, %1, %2 op_sel_hi:[1,0]" : "=v"(t) : "v"(a), "v"(b));
    asm("v_pk_fma_f32 %0, %1, %2, %3 op_sel:[1,1,0] op_sel_hi:[0,1,1] neg_lo:[1,0,0]" : "=v"(r) : "v"(a), "v"(b), "v"(t));
    return r; }
HD cf cmulc(cf a, cf b) { cf t, r;
    asm("v_pk_mul_f32 %0, %1, %2 op_sel_hi:[1,0]" : "=v"(t) : "v"(a), "v"(b));
    asm("v_pk_fma_f32 %0, %1, %2, %3 op_sel:[1,1,0] op_sel_hi:[0,1,1] neg_hi:[1,0,0]" : "=v"(r) : "v"(a), "v"(b), "v"(t));
    return r; }
HD cf cmul_s(cf a, cf b) { cf t, r;
    asm("v_pk_mul_f32 %0, %1, %2 op_sel_hi:[1,0]" : "=v"(t) : "v"(a), "s"(b));
    asm("v_pk_fma_f32 %0, %1, %2, %3 op_sel:[1,1,0] op_sel_hi:[0,1,1] neg_lo:[1,0,0]" : "=v"(r) : "v"(a), "s"(b), "v"(t));
    return r; }
HD cf cmulc_s(cf a, cf b) { cf t, r;
    asm("v_pk_mul_f32 %0, %1, %2 op_sel_hi:[1,0]" : "=v"(t) : "v"(a), "s"(b));
    asm("v_pk_fma_f32 %0, %1, %2, %3 op_sel:[1,1,0] op_sel_hi:[0,1,1] neg_hi:[1,0,0]" : "=v"(r) : "v"(a), "s"(b), "v"(t));
    return r; }
#else
HD cf cmul_s(cf a, cf b) { cf r; r.x = a.x * b.x - a.y * b.y; r.y = a.x * b.y + a.y * b.x; return r; }
HD cf cmulc_s(cf a, cf b) { cf r; r.x = a.x * b.x + a.y * b.y; r.y = a.y * b.x - a.x * b.y; return r; }
HD cf cmul(cf a, cf b) { cf r; r.x = a.x * b.x - a.y * b.y; r.y = a.x * b.y + a.y * b.x; return r; }
HD cf cmulc(cf a, cf b) { cf r; r.x = a.x * b.x + a.y * b.y; r.y = a.y * b.x - a.x * b.y; return r; }
#endif
HD cf cadd(cf a, cf b) { cf r; r.x = a.x + b.x; r.y = a.y + b.y; return r; }
HD cf csub(cf a, cf b) { cf r; r.x = a.x - b.x; r.y = a.y - b.y; return r; }
HD int PADI(int i) { return i + (i >> 4); }
template <int X> HD cf c16() {
    constexpr float C[8] = {1.f, 0.92387953251128674f, 0.70710678118654752f, 0.38268343236508977f, 0.f, -0.38268343236508977f, -0.70710678118654752f, -0.92387953251128674f};
    constexpr float S[8] = {0.f, -0.38268343236508977f, -0.70710678118654752f, -0.92387953251128674f, -1.f, -0.92387953251128674f, -0.70710678118654752f, -0.38268343236508977f};
    cf r; r.x = C[X]; r.y = S[X]; return r;
}
template <int X, bool CONJ> HD cf mulc16(cf v) {
    constexpr float R = 0.70710678118654752f; cf r;
    if constexpr (X == 0) { r = v; }
    else if constexpr (X == 4) {
#ifdef __HIPCC__
        cf c; c.x = CONJ ? -1.f : 1.f; c.y = CONJ ? 1.f : -1.f;
        asm("v_pk_mul_f32 %0, %1, %2 op_sel:[1,0] op_sel_hi:[0,1]" : "=v"(r) : "v"(v), "s"(c));
#else
        if (!CONJ) { r.x = v.y; r.y = -v.x; } else { r.x = -v.y; r.y = v.x; }
#endif
    }
    else { const cf c = c16<X>(); r = CONJ ? cmulc_s(v, c) : cmul_s(v, c); }
    return r;
}
template <int J, int Q, int I, bool INV> HD void bfly(cf (&v)[16]) {
    constexpr int hk = 8 >> J; constexpr int X = I * (8 / hk);
    const cf a = v[Q + I], b = v[Q + I + hk];
    if (!INV) { v[Q + I] = cadd(a, b); v[Q + I + hk] = mulc16<X, false>(csub(a, b)); }
    else { const cf bb = mulc16<X, true>(b); v[Q + I] = cadd(a, bb); v[Q + I + hk] = csub(a, bb); }
}
template <int J, bool INV> HD void stage16(cf (&v)[16]) {
    if constexpr (J == 0) { bfly<0,0,0,INV>(v); bfly<0,0,1,INV>(v); bfly<0,0,2,INV>(v); bfly<0,0,3,INV>(v); bfly<0,0,4,INV>(v); bfly<0,0,5,INV>(v); bfly<0,0,6,INV>(v); bfly<0,0,7,INV>(v); }
    if constexpr (J == 1) { bfly<1,0,0,INV>(v); bfly<1,0,1,INV>(v); bfly<1,0,2,INV>(v); bfly<1,0,3,INV>(v); bfly<1,8,0,INV>(v); bfly<1,8,1,INV>(v); bfly<1,8,2,INV>(v); bfly<1,8,3,INV>(v); }
    if constexpr (J == 2) { bfly<2,0,0,INV>(v); bfly<2,0,1,INV>(v); bfly<2,4,0,INV>(v); bfly<2,4,1,INV>(v); bfly<2,8,0,INV>(v); bfly<2,8,1,INV>(v); bfly<2,12,0,INV>(v); bfly<2,12,1,INV>(v); }
    if constexpr (J == 3) { bfly<3,0,0,INV>(v); bfly<3,2,0,INV>(v); bfly<3,4,0,INV>(v); bfly<3,6,0,INV>(v); bfly<3,8,0,INV>(v); bfly<3,10,0,INV>(v); bfly<3,12,0,INV>(v); bfly<3,14,0,INV>(v); }
}
constexpr int bitrev4(int k) { return ((k & 1) << 3) | ((k & 2) << 1) | ((k & 4) >> 1) | ((k & 8) >> 3); }
template <int M_LAST, bool INV> HD void fft_pass16(LDSP cf* buf, int g, cf W) {
    const int lo = g & (M_LAST - 1); const int base = (g / M_LAST) * (M_LAST * 16) + lo;
    cf v[16];
#pragma unroll
    for (int k = 0; k < 16; ++k) v[k] = buf[PADI(base + k * M_LAST)];
#ifdef __HIPCC__
    asm volatile("" : "+v"(W));
#endif
    if (!INV) { stage16<0, false>(v); stage16<1, false>(v); stage16<2, false>(v); stage16<3, false>(v);
        cf cur = W;
#pragma unroll
        for (int e = 1; e < 16; ++e) { v[bitrev4(e)] = cmul(v[bitrev4(e)], cur); if (e < 15) cur = cmul(cur, W); } }
    else {
        cf cur = W;
#pragma unroll
        for (int e = 1; e < 16; ++e) { v[bitrev4(e)] = cmulc(v[bitrev4(e)], cur); if (e < 15) cur = cmul(cur, W); }
        stage16<3, true>(v); stage16<2, true>(v); stage16<1, true>(v); stage16<0, true>(v); }
#pragma unroll
    for (int k = 0; k < 16; ++k) buf[PADI(base + k * M_LAST)] = v[k];
}
HD void fft_last_scale(LDSP cf* buf, int g, float sc) {
#pragma unroll
    for (int p = 0; p < 8; ++p) { const int i0 = PADI(16 * g + 2 * p), i1 = PADI(16 * g + 2 * p + 1); const cf a = buf[i0], b = buf[i1];
        cf s = cadd(a, b), d = csub(a, b); s.x *= sc; s.y *= sc; d.x *= sc; d.y *= sc; buf[i0] = s; buf[i1] = d; }
}
HD void fft_middle(LDSP cf* buf, const LDSP cf* H, int g) {
#pragma unroll
    for (int p = 0; p < 8; ++p) { const int i0 = PADI(16 * g + 2 * p), i1 = PADI(16 * g + 2 * p + 1); const cf a = buf[i0], b = buf[i1];
        const cf s = cmul(cadd(a, b), H[i0]), d = cmul(csub(a, b), H[i1]); buf[i0] = cadd(s, d); buf[i1] = csub(s, d); }
}
#undef HD
#undef LDSP
__device__ __forceinline__ cf tw_of(float frac) { cf r; r.x = __builtin_amdgcn_cosf(frac); r.y = -__builtin_amdgcn_sinf(frac); return r; }
__device__ __forceinline__ float xshfl(float v, int o, int l) { return __builtin_bit_cast(float, __builtin_amdgcn_ds_bpermute((l ^ o) << 2, __builtin_bit_cast(int, v))); }
__device__ __forceinline__ void fft_fwd3(LAS cf* buf, int tid, cf W0, cf W1, cf W2) {
    fft_pass16<512, false>(buf, tid, W0); __syncthreads(); fft_pass16<32, false>(buf, tid, W1); __syncthreads(); fft_pass16<2, false>(buf, tid, W2); __syncthreads();
}
__device__ __forceinline__ void fft_inv3(LAS cf* buf, int tid, cf W0, cf W1, cf W2) {
    fft_pass16<2, true>(buf, tid, W2); __syncthreads(); fft_pass16<32, true>(buf, tid, W1); __syncthreads(); fft_pass16<512, true>(buf, tid, W0); __syncthreads();
}
__device__ __forceinline__ float block_sum(float v, LAS float* red, int tid) {
    v = wave_sum(v); __syncthreads(); if ((tid & 63) == 0) red[tid >> 6] = v; __syncthreads();
    float s = 0.f;
#pragma unroll
    for (int i = 0; i < 8; ++i) s += red[i];
    return s;
}
__device__ __forceinline__ float sconv(const bf16_t* uc, int b, int ch, int t, float w0, float w1, float w2, float cb) {
    const bf16_t* u = uc + (((size_t)(b * 1536 + ch)) << 12) + t;
    const float xm = bf2f(u[t > 0 ? -1 : 0]), u0 = bf2f(u[0]), xp = bf2f(u[t < SEQ - 1 ? 1 : 0]);
    const float um = t > 0 ? xm : 0.f, up = t < SEQ - 1 ? xp : 0.f;
    return cb + w0 * um + w1 * u0 + w2 * up;
}
__device__ __forceinline__ void sconv8(const bf16_t* uc, int b, int ch, int tid, float w0, float w1, float w2, float cb, float (&out)[8]) {
    const bf16_t* u = uc + (((size_t)(b * 1536 + ch)) << 12) + 8 * tid;
    const u32x4 raw = *(const u32x4*)u;
    const float pv = bf2f(u[tid > 0 ? -1 : 0]), nx = bf2f(u[tid < 511 ? 8 : 7]);
    float x[10]; x[0] = tid > 0 ? pv : 0.f; x[9] = tid < 511 ? nx : 0.f;
#pragma unroll
    for (int i = 0; i < 4; ++i) { x[1 + 2 * i] = __builtin_bit_cast(float, raw[i] << 16); x[2 + 2 * i] = __builtin_bit_cast(float, raw[i] & 0xffff0000u); }
#pragma unroll
    for (int j = 0; j < 8; ++j) out[j] = cb + w0 * x[j] + w1 * x[j + 1] + w2 * x[j + 2];
}
__device__ __forceinline__ void hyena_block(CArgs& a, LAS unsigned char* lds, int blk, int wv) {
    const int tid = tid_opaque(wv);
    unsigned char* ws = a.ws;
    LAS cf* A = (LAS cf*)lds; LAS cf* Hb = (LAS cf*)(lds + FFT_BUF); LAS float* wl = (LAS float*)(lds + 2 * FFT_BUF); LAS float* red = wl + 512; LAS float* scl = red + 8;
    const float* hid3 = (const float*)(ws + WS_HID3); const bf16_t* uc = (const bf16_t*)(ws + WS_UC); bf16_t* yc = (bf16_t*)(ws + WS_YC);
    float* fs = a.out + (size_t)blk * 4 * 8192;
    cf* z1 = (cf*)(ws + WS_Z1) + (size_t)blk * 2 * 4096;
    const cf W0 = tw_of((float)tid * (1.f / 8192.f)), W1 = tw_of((float)(tid & 31) * (1.f / 512.f)), W2 = tw_of((float)(tid & 1) * (1.f / 32.f));
#ifndef PROBE_PHASE
#define PROBE_PHASE -1
#endif
    for (int rp = 0; rp < ((PROBE_PHASE == 41) ? 2 : 1); ++rp) {
    __syncthreads();
    { const int f = tid >> 6, j = tid & 63, ci = f >> 2, o = (f >> 1) & 1, dir = f & 1;
      wl[tid] = a.in[I_HWOUT][(size_t)j * 2048 + o * 1024 + dir * 512 + blk + ci * 256]; }
    __syncthreads();
    LAS float* F = (LAS float*)lds;
    float ssq_l = 0.f;
    { const int lane = tid & 63, wvv = tid >> 6, rsub = lane >> 4, q = lane & 15, fsel = q >> 1, fo = fsel >> 1, dir = fsel & 1;
      int lop = lane; asm volatile("" : "+v"(lop));
      f32x4 w[8];
#pragma unroll
      for (int f = 0; f < 8; ++f) w[f] = *(const LAS f32x4*)(wl + f * 64 + 4 * q);
      const float mydec = fabsf(a.in[I_DECAY][(((fsel >> 1) & 1) * 2 + dir) * 512 + blk + (fsel >> 2) * 256]);
      const float* hbase = hid3 + (size_t)(512 * wvv + rsub) * 64 + 4 * q;
#define SWEEP_LOAD(HB, IB) do { _Pragma("unroll") for (int ii = 0; ii < 16; ++ii) HB[ii] = *(const f32x4*)(hbase + (size_t)(16 * (IB) + ii) * 256); } while (0)
#define SWEEP_PROC(HB, IB) do { _Pragma("unroll") for (int ii = 0; ii < 16; ++ii) { const int it = 16 * (IB) + ii; const int row = 512 * wvv + 4 * it + rsub; const f32x4 h = HB[ii]; \
          float p[8]; \
          _Pragma("unroll") for (int f = 0; f < 8; ++f) p[f] = (h[0] * w[f][0] + h[1] * w[f][1]) + (h[2] * w[f][2] + h[3] * w[f][3]); \
          float p1[4], p2[2]; \
          _Pragma("unroll") for (int jj = 0; jj < 4; ++jj) { const float snd = (q & 8) ? p[jj] : p[jj + 4], kp = (q & 8) ? p[jj + 4] : p[jj]; p1[jj] = kp + xshfl(snd, 8, lop); } \
          _Pragma("unroll") for (int jj = 0; jj < 2; ++jj) { const float snd = (q & 4) ? p1[jj] : p1[jj + 2], kp = (q & 4) ? p1[jj + 2] : p1[jj]; p2[jj] = kp + xshfl(snd, 4, lop); } \
          float p3; { const float snd = (q & 2) ? p2[0] : p2[1], kp = (q & 2) ? p2[1] : p2[0]; p3 = kp + xshfl(snd, 2, lop); } \
          p3 += xshfl(p3, 1, lop); \
          if ((q & 1) == 0) { const float tt = (float)row * (1.f / (float)(SEQ - 1)); float val = p3 * __expf(-tt * mydec); \
              int idx = dir ? 8192 - row : row; if (dir && row == 0) { idx = 4096; val = 0.f; } \
              F[(fsel >> 1) * 8192 + idx] = val; ssq_l += val * val; } } } while (0)
      { f32x4 hbA[16], hbB[16];
        SWEEP_LOAD(hbA, 0);
#pragma unroll 1
        for (int ib = 0; ib < 8; ib += 2) { SWEEP_LOAD(hbB, ib + 1); SWEEP_PROC(hbA, ib); if (ib + 2 < 8) SWEEP_LOAD(hbA, ib + 2); SWEEP_PROC(hbB, ib + 1); } }
#undef SWEEP_LOAD
#undef SWEEP_PROC
#pragma unroll
      for (int k = 0; k < 4; ++k) { const float s = block_sum(((q & 1) == 0 && (fsel >> 1) == k) ? ssq_l : 0.f, red, tid); if (tid == 0) scl[k] = rsqrtf(s) * (1.f / 8192.f); }
    }
    __syncthreads();
#pragma unroll
    for (int fo = 0; fo < 4; ++fo) { float* dst = fs + (size_t)fo * 8192; const LAS float* src = F + fo * 8192;
#pragma unroll
        for (int i = 0; i < 8; ++i) { const int t = tid + 512 * i, tb = t >= 1 ? 8192 - t : 4096; const float va = src[t], vb = src[tb]; dst[t] = va; dst[tb] = vb; } }
    __syncthreads();
    }
    const float* cw = a.in[I_CONVW]; const float* cbv = a.in[I_CONVB];
    for (int ci = 0; ci < 2; ++ci) { const int c = blk + ci * 256;
        for (int o = 0; o < 2; ++o) {
            { const float* src = fs + (size_t)(ci * 2 + o) * 8192; float fa[8], fb[8];
#pragma unroll
              for (int i = 0; i < 8; ++i) { const int t = tid + 512 * i, tb = t >= 1 ? 8192 - t : 4096; fa[i] = src[t]; fb[i] = src[tb]; }
#pragma unroll
              for (int i = 0; i < 8; ++i) { const int t = tid + 512 * i, tb = t >= 1 ? 8192 - t : 4096; cf v; v.y = 0.f; v.x = fa[i]; Hb[PADI(t)] = v; v.x = fb[i]; Hb[PADI(tb)] = v; } }
            __syncthreads();
#if PROBE_PHASE == 42
            fft_fwd3(Hb, tid, W0, W1, W2); fft_inv3(Hb, tid, W0, W1, W2);
            fft_fwd3(Hb, tid, W0, W1, W2);
            fft_last_scale(Hb, tid, scl[ci * 2 + o] * (1.f / 4096.f));
#else
            fft_fwd3(Hb, tid, W0, W1, W2);
            fft_last_scale(Hb, tid, scl[ci * 2 + o]);
#endif
            __syncthreads();
            const int zch = 1024 + c, gch = o * 512 + c;
            const float zw0 = cw[zch], zw1 = cw[1536 + zch], zw2 = cw[3072 + zch], zcb = cbv[zch];
            const float gw0 = cw[gch], gw1 = cw[1536 + gch], gw2 = cw[3072 + gch], gcb = cbv[gch];
            const float bias = a.in[I_HBIAS][o * 512 + c];
            for (int bp = 0; bp < 2; ++bp) { const int b0 = 2 * bp, b1 = 2 * bp + 1;
                cf zz[8];
                { if (o == 0) { float za[8], zb[8]; sconv8(uc, b0, zch, tid, zw0, zw1, zw2, zcb, za); sconv8(uc, b1, zch, tid, zw0, zw1, zw2, zcb, zb);
#pragma unroll
                      for (int j = 0; j < 8; ++j) { zz[j].x = za[j]; zz[j].y = zb[j]; } }
                  else { const f32x4* zp = (const f32x4*)(z1 + bp * 4096 + 8 * tid);
#pragma unroll
                      for (int j = 0; j < 4; ++j) { const f32x4 q4 = zp[j]; zz[2 * j].x = q4[0]; zz[2 * j].y = q4[1]; zz[2 * j + 1].x = q4[2]; zz[2 * j + 1].y = q4[3]; } }
#pragma unroll
                  for (int j = 0; j < 8; ++j) { A[PADI(8 * tid + j)] = zz[j]; cf zero; zero.x = 0.f; zero.y = 0.f; A[PADI(4096 + 8 * tid + j)] = zero; } }
                float ga[8], gb[8]; sconv8(uc, b0, gch, tid, gw0, gw1, gw2, gcb, ga); sconv8(uc, b1, gch, tid, gw0, gw1, gw2, gcb, gb);
                __syncthreads();
                fft_fwd3(A, tid, W0, W1, W2);
                fft_middle(A, Hb, tid); __syncthreads();
                fft_inv3(A, tid, W0, W1, W2);
                {
                  float r0[8], r1[8];
#pragma unroll
                  for (int j = 0; j < 8; ++j) { const cf y = A[PADI(8 * tid + j)]; r0[j] = ga[j] * (y.x + zz[j].x * bias); r1[j] = gb[j] * (y.y + zz[j].y * bias); }
                  if (o == 0) { f32x4* zp = (f32x4*)(z1 + bp * 4096 + 8 * tid);
#pragma unroll
                      for (int j = 0; j < 4; ++j) zp[j] = (f32x4){r0[2 * j], r1[2 * j], r0[2 * j + 1], r1[2 * j + 1]}; }
                  else { u32x4 w0v, w1v;
#pragma unroll
                      for (int j = 0; j < 4; ++j) { w0v[j] = cvt_pk_bf16(r0[2 * j], r0[2 * j + 1]); w1v[j] = cvt_pk_bf16(r1[2 * j], r1[2 * j + 1]); }
                      *(u32x4*)(yc + (((size_t)(b0 * 512 + c)) << 12) + 8 * tid) = w0v; *(u32x4*)(yc + (((size_t)(b1 * 512 + c)) << 12) + 8 * tid) = w1v; } }
                __syncthreads();
            }
        }
    }
}
__device__ __forceinline__ void transpose_tiles(const bf16_t* yc, bf16_t* y, LAS unsigned char* lds, int nblk, int iblk, int wv) {
    const int tid = tid_opaque(wv), lane = tid & 63, wave = tid >> 6;
    LAS bf16_t* s = (LAS bf16_t*)(lds + wave * 16384);
    for (int tile = iblk * 8 + wave; tile < 4 * 8 * 64; tile += nblk * 8) { const int b = tile >> 9, cb = (tile >> 6) & 7, tb = tile & 63;
        const bf16_t* src = yc + (((size_t)(b * 512 + cb * 64)) << 12) + tb * 64 + lane;
        bf16_t tv[64];
#pragma unroll
        for (int i = 0; i < 64; ++i) tv[i] = src[(size_t)i << 12];
#pragma unroll
        for (int i = 0; i < 64; ++i) s[i * 66 + lane] = tv[i];
        asm volatile("s_waitcnt lgkmcnt(0)" ::: "memory");
        bf16_t* dst = y + ((size_t)b * SEQ + tb * 64) * 1024 + 512 + cb * 64 + lane;
#pragma unroll 8
        for (int i = 0; i < 64; ++i) dst[(size_t)i * 1024] = s[lane * 66 + i];
        asm volatile("s_waitcnt lgkmcnt(0)" ::: "memory");
    }
}

#define XB_TMO      128
#define XB_XCNT(j)  (256  + 64 * (j))
#define XB_XSUB(j)  (1280 + 64 * (j))
#define XB_XGEN(j)  (2304 + 64 * (j))
#define XB_TOP      3328
#define XB_TOPGEN   3392
#define XCD_BAR_WORDS 3456
#define XB_SPIN_CAP (1u << 18)
__device__ __forceinline__ unsigned xb_ld(unsigned* p)              { return __hip_atomic_load(p, __ATOMIC_RELAXED, __HIP_MEMORY_SCOPE_AGENT); }
__device__ __forceinline__ unsigned xb_add(unsigned* p, unsigned v) { return __hip_atomic_fetch_add(p, v, __ATOMIC_RELAXED, __HIP_MEMORY_SCOPE_AGENT); }
__device__ __forceinline__ unsigned xb_xcc_id() { return (unsigned)__builtin_amdgcn_s_getreg((3 << 11) | 20) & 0xFu; }
#define XB_SPIN(cond, bar) do { unsigned _sp = 0; while (cond) { __builtin_amdgcn_s_sleep(1); \
    if ((++_sp & 255u) == 0u) { if (xb_ld(&(bar)[XB_TMO])) break; if (_sp > XB_SPIN_CAP) { atomicAdd(&(bar)[XB_TMO], 1u); break; } } } } while (0)
struct XcdBarrier { unsigned* bar; unsigned x; volatile LAS unsigned* st; };
__device__ __forceinline__ XcdBarrier xcd_barrier_post(unsigned* bar, volatile LAS unsigned* st) {
    XcdBarrier b; b.bar = bar; b.x = xb_xcc_id(); b.st = st;
    if (threadIdx.x == 0) (void)xb_add(&bar[XB_XCNT(b.x)], 1u);
    return b;
}
__device__ __forceinline__ void xcd_barrier_complete(unsigned* bar, unsigned x, unsigned& nloc, unsigned& nx) {
    const unsigned G = gridDim.x * gridDim.y * gridDim.z;
    unsigned sum, cnt, mine, sp = 0u;
    for (;;) {
        sum = 0u; cnt = 0u; mine = 0u;
#pragma unroll
        for (unsigned j = 0; j < 16; ++j) { const unsigned c = xb_ld(&bar[XB_XCNT(j)]); sum += c; cnt += (c > 0u) ? 1u : 0u; mine = (j == x) ? c : mine; }
        if (sum == G) break;
        __builtin_amdgcn_s_sleep(1);
        if ((++sp & 255u) == 0u) { if (xb_ld(&bar[XB_TMO])) break; if (sp > XB_SPIN_CAP) { atomicAdd(&bar[XB_TMO], 1u); break; } }
    }
    nloc = mine > 0u ? mine : 1u; nx = cnt > 0u ? cnt : 1u;
}
__device__ __forceinline__ void xcd_barrier(unsigned* bar_, volatile LAS unsigned* st_, int wv) {
    XcdBarrier b; b.bar = bar_; b.st = st_; b.x = 0u;
    asm volatile("s_waitcnt vmcnt(0)" ::: "memory");
    __syncthreads();
    if (tid_opaque(wv) == 0) {
        unsigned* bar = b.bar; b.x = xb_xcc_id();
        __builtin_amdgcn_s_waitcnt(0);
        unsigned nloc = b.st[0], nx = b.st[1];
        if (nloc == 0u) { xcd_barrier_complete(bar, b.x, nloc, nx); b.st[0] = nloc; b.st[1] = nx; }
        const unsigned old = xb_add(&bar[XB_XSUB(b.x)], 1u);
        const unsigned gen = old / nloc;
        if (old + 1u == (gen + 1u) * nloc) {
            __builtin_amdgcn_fence(__ATOMIC_RELEASE, "agent");
            asm volatile("s_waitcnt vmcnt(0)" ::: "memory");
            const unsigned og = xb_add(&bar[XB_TOP], 1u);
            const unsigned tg = og / nx;
            if (og + 1u == (tg + 1u) * nx) xb_add(&bar[XB_TOPGEN], 1u);
            else XB_SPIN(xb_ld(&bar[XB_TOPGEN]) == tg, bar);
            __builtin_amdgcn_fence(__ATOMIC_ACQUIRE, "agent");
            xb_add(&bar[XB_XGEN(b.x)], 1u);
            asm volatile("s_waitcnt vmcnt(0)" ::: "memory");
        } else {
            XB_SPIN(xb_ld(&bar[XB_XGEN(b.x)]) == gen, bar);
            __builtin_amdgcn_fence(__ATOMIC_ACQUIRE, "agent");
            asm volatile("s_waitcnt vmcnt(0)" ::: "memory");
        }
    }
    __syncthreads();
}

constexpr int NPH = 18;
__global__ void __launch_bounds__(512, 2) mega_fwd(Args a) {
    extern __shared__ __attribute__((aligned(16))) unsigned char lds_raw[];
    cg::grid_group grid = cg::this_grid();
    LAS unsigned char* lds = (LAS unsigned char*)lds_raw;
    const int G = gridDim.x, bx = blockIdx.x;
    const int wv = __builtin_amdgcn_readfirstlane((int)(threadIdx.x >> 6));
    const int vcu = (G % 8 == 0) ? (bx % 8) * (G / 8) + bx / 8 : bx;
    unsigned char* ws = a.ws;
    float* ssq = (float*)(ws + WS_SSQ); float* ssq_q = (float*)(ws + WS_SSQQ); float* ssq_kv = (float*)(ws + WS_SSQKV);
    bf16_t* XB = (bf16_t*)(ws + WS_XB); bf16_t* ACT = (bf16_t*)(ws + WS_ACT);
    float* X = a.out;
    const int lo = a.ph_lo, hi = a.ph_hi;
    volatile LAS unsigned* bst = (volatile LAS unsigned*)(lds + LDS_BYTES - 16);
    if (threadIdx.x < 2) bst[threadIdx.x] = 0u;
    __syncthreads();
    (void)xcd_barrier_post((unsigned*)(ws + WS_BAR), bst);
    if (lo < 0) grid.sync();
#ifndef PH_MASK
#define PH_MASK 0x3ffff
#endif
#define IN(k) ((((PH_MASK) >> (k)) & 1) && lo <= (k) && (k) < hi)
#ifndef PROBE_PHASE
#define PROBE_PHASE -1
#endif
#ifndef PROBE_SYNC
#define PROBE_SYNC 0
#endif
#define NREP(k) (((k) == PROBE_PHASE) ? 2 : 1)
#define SEAM(k) do { if (IN(k) && IN((k) + 1)) { xcd_barrier((unsigned*)(ws + WS_BAR), bst, wv); if (PROBE_SYNC) xcd_barrier((unsigned*)(ws + WS_BAR), bst, wv); } } while (0)
#define FFN_UP(k, f, sidx) if (IN(k)) for (int rep = 0; rep < NREP(k); ++rep) { pg8::Gemm g{XB, (const bf16_t*)(ws + WS_WGU) + (size_t)(f) * 5632 * DM, MTOK, 5632, DM, DM}; pg8::StaticOrder S; S.init(MTOK, 5632, G, bx); \
        EpiAct E{ACT, ssq + (sidx) * MTOK}; pg8::gemm_phase<EpiAct, pg8::StaticOrder, true, true>(lds, g, S, E, wv); }
#define FFN_DN(k, f, xin_, sidx) if (IN(k)) { pg8::Gemm g{ACT, (const bf16_t*)(ws + WS_WD) + (size_t)(f) * DM * FF, MTOK, DM, FF, FF}; pg8::StaticOrder S; S.init(MTOK, DM, G, bx); \
        EpiRes E{(xin_), XB, ssq + (sidx) * MTOK, 0.5f}; pg8::gemm_phase<EpiRes, pg8::StaticOrder, true, true>(lds, g, S, E, wv); } SEAM(k);

    if (IN(0)) for (int rep = 0; rep < NREP(0); ++rep) p0_prologue(*opaque_args(), lds, G, vcu, wv);
    SEAM(0);
    FFN_UP(1, 0, 0)
#define DEFER_CONVERT(k, sets) if (IN(k) && G == 256 && bx >= 128) { convert_jobs(*opaque_args(), lds, (sets), (bx - 128) * 8 + wv, 128 * 8, wv); }
    DEFER_CONVERT(1, 2)
    SEAM(1);
    FFN_DN(2, 0, (const float*)nullptr, 1)
#if PROBE_PHASE == 100
    if (IN(2)) { xcd_barrier((unsigned*)(ws + WS_BAR), bst, wv); pg8::Gemm g{ACT, (const bf16_t*)(ws + WS_WD), MTOK, DM, FF, FF}; pg8::StaticOrder S; S.init(MTOK, DM, G, bx);
        EpiPlain E{(bf16_t*)(ws + WS_BIG + 88 * MiB), 1024}; pg8::gemm_phase<EpiPlain, pg8::StaticOrder, false, true>(lds, g, S, E, wv); }
#endif
    if (IN(3)) for (int rep = 0; rep < NREP(3); ++rep) { pg8::Gemm g{XB, (const bf16_t*)(ws + WS_WIN), MTOK, 2048, DM, DM}; pg8::StaticOrder S; S.init(MTOK, 2048, G, bx);
        EpiMixIn E{(bf16_t*)(ws + WS_APOOL), (bf16_t*)(ws + WS_UC), ssq + 1 * MTOK}; pg8::gemm_phase<EpiMixIn, pg8::StaticOrder, true, true>(lds, g, S, E, wv); }
    SEAM(3);
    if (IN(4)) for (int rep = 0; rep < NREP(4); ++rep) {
        for (int rp = 0; rp < ((PROBE_PHASE == 40) ? 2 : 1); ++rp)
        for (int it = bx; it < 256; it += G) pool_item((const bf16_t*)(ws + WS_APOOL), (bf16_t*)(ws + WS_PP), it, wv);
        for (int blk = bx; blk < 256; blk += G) { __syncthreads(); hyena_block(*opaque_args(), lds, blk, wv); }
    }
    SEAM(4);
    if (IN(5)) for (int rep = 0; rep < NREP(5); ++rep) {
        __syncthreads();
        if (G == 256) { if (bx >= 128) transpose_tiles((const bf16_t*)(ws + WS_YC), (bf16_t*)(ws + WS_Y), lds, 128, bx - 128, wv); }
        else transpose_tiles((const bf16_t*)(ws + WS_YC), (bf16_t*)(ws + WS_Y), lds, G, bx, wv);
        __syncthreads();
        pg8::Gemm g{(const bf16_t*)(ws + WS_PP), (const bf16_t*)(ws + WS_WPOOL), MTOK, 512, 512, 512}; pg8::StaticOrder S; S.init(MTOK, 512, G, bx);
        EpiPlain E{(bf16_t*)(ws + WS_Y), 1024}; pg8::gemm_phase<EpiPlain, pg8::StaticOrder, true, true>(lds, g, S, E, wv);
    }
    SEAM(5);
    if (IN(6)) { pg8::Gemm g{(const bf16_t*)(ws + WS_Y), (const bf16_t*)(ws + WS_WOUT), MTOK, DM, DM, DM}; pg8::StaticOrder S; S.init(MTOK, DM, G, bx);
        EpiRes E{nullptr, XB, ssq + 2 * MTOK, 1.0f}; pg8::gemm_phase<EpiRes, pg8::StaticOrder, true, true>(lds, g, S, E, wv); }
    SEAM(6);
    FFN_UP(7, 1, 2)
    DEFER_CONVERT(7, 4)
    SEAM(7);
    FFN_DN(8, 1, (const float*)nullptr, 3)
    FFN_UP(9, 2, 3)
    DEFER_CONVERT(9, 8)
    SEAM(9);
    FFN_DN(10, 2, (const float*)nullptr, 4)
    if (IN(11)) { pg8::Gemm g{XB, (const bf16_t*)(ws + WS_WD1), MTOK, 512, DM, DM}; pg8::StaticOrder S; S.init(MTOK, 512, G, bx);
        EpiM1 E{(bf16_t*)(ws + WS_A2), (bf16_t*)(ws + WS_KR), ssq + 4 * MTOK, ssq_q}; pg8::gemm_phase<EpiM1, pg8::StaticOrder, true, true>(lds, g, S, E, wv); }
    SEAM(11);
    if (IN(12)) for (int rep = 0; rep < NREP(12); ++rep) {
        { pg8::Gemm g{(const bf16_t*)(ws + WS_A2), (const bf16_t*)(ws + WS_WUP), MTOK, 1536, 256, 384}; pg8::StaticOrder S; S.init(MTOK, 1536, G, bx);
          EpiM2 E{(bf16_t*)(ws + WS_Q), (bf16_t*)(ws + WS_KV), ssq_q, ssq_kv, 0}; pg8::gemm_phase<EpiM2, pg8::StaticOrder, true, true>(lds, g, S, E, wv); }
        { pg8::Gemm g{(const bf16_t*)(ws + WS_A2) + 128, (const bf16_t*)(ws + WS_WUP) + (size_t)1536 * 384 + 128, MTOK, 2048, 256, 384}; pg8::StaticOrder S; S.init(MTOK, 2048, G, bx);
          EpiM2 E{(bf16_t*)(ws + WS_Q), (bf16_t*)(ws + WS_KV), ssq_q, ssq_kv, 6}; pg8::gemm_phase<EpiM2, pg8::StaticOrder, true, true>(lds, g, S, E, wv); } }
    SEAM(12);
    if (IN(13)) for (int rep = 0; rep < NREP(13); ++rep) {
        for (int u = vcu; u < NB * 16 * 16; u += G) { const int bh = u >> 4, qb = u & 15;
            att::attn_unit((const bf16_t*)(ws + WS_Q), (const bf16_t*)(ws + WS_KV), (const bf16_t*)(ws + WS_KR), (bf16_t*)(ws + WS_O), bh >> 4, bh & 15, qb, (char*)lds_raw, wv); }
    }
    SEAM(13);
    if (IN(14)) { pg8::Gemm g{(const bf16_t*)(ws + WS_O), (const bf16_t*)(ws + WS_WO), MTOK, DM, DM, DM}; pg8::StaticOrder S; S.init(MTOK, DM, G, bx);
        EpiRes E{nullptr, XB, ssq + 5 * MTOK, 1.0f}; pg8::gemm_phase<EpiRes, pg8::StaticOrder, true, true>(lds, g, S, E, wv); }
    SEAM(14);
    FFN_UP(15, 3, 5)
    SEAM(15);
    if (IN(16)) {
        if (G == 256) {
            pg8::Gemm g{ACT, (const bf16_t*)(ws + WS_WD) + (size_t)3 * DM * FF, MTOK, DM, FF, FF}; pg8::StaticOrder S; S.init(MTOK, DM, G, bx);
            EpiResFinal E{XB, ssq + 6 * MTOK, (unsigned*)(ws + WS_CNT), opaque_args()->in[I_FNG], X, 0.5f, wv}; pg8::gemm_phase<EpiResFinal, pg8::StaticOrder, true, true>(lds, g, S, E, wv);
        } else {
            pg8::Gemm g{ACT, (const bf16_t*)(ws + WS_WD) + (size_t)3 * DM * FF, MTOK, DM, FF, FF}; pg8::StaticOrder S; S.init(MTOK, DM, G, bx);
            EpiRes E{nullptr, XB, ssq + 6 * MTOK, 0.5f}; pg8::gemm_phase<EpiRes, pg8::StaticOrder, true, true>(lds, g, S, E, wv);
        }
    }
    if (G != 256) SEAM(16);
    if (IN(17) && G != 256) {
        const int lane = tid_opaque(wv) & 63, gw = vcu * 8 + wv; const float* gf = opaque_args()->in[I_FNG];
        for (int m = gw; m < MTOK; m += G * 8) { const float rs = rsqrtf(ssq[6 * MTOK + m] * (1.f / DM) + EPS);
            const u32x2* xr = (const u32x2*)(XB + (size_t)m * DM) + lane; f32x4* orow = (f32x4*)(X + (size_t)m * DM) + lane;
#pragma unroll
            for (int j = 0; j < 4; ++j) { const u32x2 w = xr[64 * j]; const f32x4 gv = ((const f32x4*)gf)[lane + 64 * j];
                const f32x4 xv = {__builtin_bit_cast(float, w.x << 16), __builtin_bit_cast(float, w.x & 0xffff0000u), __builtin_bit_cast(float, w.y << 16), __builtin_bit_cast(float, w.y & 0xffff0000u)};
                orow[64 * j] = xv * rs * gv; } }
    }
#undef IN
#undef SEAM
#undef FFN_UP
#undef FFN_DN
}

extern "C" void kernel_launch(void* const* d_in, const int* in_sizes, int n_in, void* d_out, int out_size, void* d_ws, size_t ws_size, hipStream_t stream) {
    static int grid = 0;
    if (grid == 0) {
        if (n_in != 29 || out_size != MTOK * DM || ws_size < WS_END) { fprintf(stderr, "kernel_launch: unexpected shapes n_in %d out %d ws %zu\n", n_in, out_size, ws_size); grid = -1; return; }
        int dev = 0, cus = 0, per_cu = 0;
        if (hipGetDevice(&dev) != hipSuccess || hipDeviceGetAttribute(&cus, hipDeviceAttributeMultiprocessorCount, dev) != hipSuccess) { grid = -1; return; }
        if (hipFuncSetAttribute((const void*)mega_fwd, hipFuncAttributeMaxDynamicSharedMemorySize, LDS_BYTES) != hipSuccess) { fprintf(stderr, "kernel_launch: hipFuncSetAttribute failed\n"); grid = -1; return; }
        if (hipOccupancyMaxActiveBlocksPerMultiprocessor(&per_cu, (const void*)mega_fwd, 512, LDS_BYTES) != hipSuccess || per_cu < 1) { fprintf(stderr, "kernel_launch: occupancy query says %d\n", per_cu); per_cu = 1; }
        (void)hipGetLastError();
        grid = cus;
    }
    if (grid < 0) return;
    if (hipMemsetAsync((char*)d_ws + WS_BAR, 0, 16384, stream) != hipSuccess) { fprintf(stderr, "kernel_launch: memset failed\n"); return; }
    Args a{};
    for (int i = 0; i < 29; ++i) a.in[i] = (const float*)d_in[i];
    a.out = (float*)d_out; a.ws = (unsigned char*)d_ws; a.ph_lo = 0; a.ph_hi = NPH;
    void* args[] = {&a};
    hipError_t e = hipLaunchCooperativeKernel((const void*)mega_fwd, dim3(grid), dim3(512), args, LDS_BYTES, stream);
    if (e != hipSuccess) fprintf(stderr, "kernel_launch: cooperative launch failed: %s (grid %d)\n", hipGetErrorString(e), grid);
}
```

```cpp
#include <hip/hip_runtime.h>
#include <hip/hip_cooperative_groups.h>
#include <cstdio>
#include <cstdint>
namespace cg = cooperative_groups;

#define LAS __attribute__((address_space(3)))
typedef unsigned short bf16_t;
typedef short bf16x8 __attribute__((ext_vector_type(8)));
typedef short s16x4 __attribute__((ext_vector_type(4)));
typedef float f32x4 __attribute__((ext_vector_type(4)));
typedef float f32x16 __attribute__((ext_vector_type(16)));
typedef unsigned u32x4 __attribute__((ext_vector_type(4)));
typedef unsigned u32x2 __attribute__((ext_vector_type(2)));

__device__ __forceinline__ unsigned cvt_pk_bf16(float lo, float hi) { unsigned r; asm volatile("v_cvt_pk_bf16_f32 %0, %1, %2" : "=v"(r) : "v"(lo), "v"(hi)); return r; }
__device__ __forceinline__ unsigned f2bf(float f) { unsigned u = __builtin_bit_cast(unsigned, f); return (u + 0x7fffu + ((u >> 16) & 1u)) >> 16; }
__device__ __forceinline__ float bf2f(bf16_t b) { return __builtin_bit_cast(float, (unsigned)b << 16); }
__device__ __forceinline__ int tid_opaque(int wv) { int l = __builtin_amdgcn_mbcnt_hi(~0u, __builtin_amdgcn_mbcnt_lo(~0u, 0u)); asm volatile("" : "+v"(l)); return (wv << 6) | l; }
__device__ __forceinline__ float wave_sum(float v) {
    int l = __builtin_amdgcn_mbcnt_hi(~0u, __builtin_amdgcn_mbcnt_lo(~0u, 0u)); asm volatile("" : "+v"(l));
#pragma unroll
    for (int o = 1; o < 64; o <<= 1) v += __builtin_bit_cast(float, __builtin_amdgcn_ds_bpermute((l ^ o) << 2, __builtin_bit_cast(int, v)));
    return v;
}

namespace pg8 {
constexpr int BM = 256, BK = 64, HALF = 128, HTB = HALF * BK * 2, STAGE_BYTES = 8 * HTB, NXCD = 8, WGM = 8;
__host__ __device__ __forceinline__ int lds_byte(int r, int c) { const int st = (r >> 4) * 2 + (c >> 5), rr = r & 15, cc = c & 31, ob = rr * 64 + cc * 2; return st * 1024 + (ob ^ (((ob >> 9) & 1) << 5)); }
__host__ __device__ __forceinline__ void stage_rc(int b, int& R, int& C) { const int st = b / 1024, sb = b % 1024, swz = sb ^ (((sb >> 9) & 1) << 5); R = (st >> 1) * 16 + swz / 64; C = (st & 1) * 32 + (swz % 64) / 2; }
__host__ __device__ __forceinline__ int perm32(int rho) { const int n = rho >> 4, i = rho & 15; return 8 * (i >> 2) + 4 * n + (i & 3); }
struct Unit { int pm, pn; };
struct Gemm { const bf16_t* A; const bf16_t* Bt; int M, N, K, ld; };
struct StaticOrder {
    int nM, nN, nwg, G, c;
    __host__ __device__ void init(int M, int N, int G_, int c_) { nM = M / BM; nN = N / BM; nwg = nM * nN; G = G_; c = c_; }
    __host__ __device__ bool next(int i, Unit& u) const {
        const long L = (long)i * G + c; if (L >= nwg) return false;
        int wgid = (int)L; { const int q = nwg / NXCD, r = nwg % NXCD, xcd = wgid % NXCD, off = wgid / NXCD; wgid = (xcd < r ? xcd * (q + 1) : r * (q + 1) + (xcd - r) * q) + off; }
        const int nig = WGM * nN, gid = wgid / nig, fm = gid * WGM, gsz = (nM - fm) < WGM ? (nM - fm) : WGM;
        u.pm = fm + ((wgid % nig) % gsz); u.pn = (wgid % nig) / gsz; return true;
    }
    __device__ __forceinline__ void a_ready(const Unit&) const {}
    __device__ __forceinline__ void done(const Unit&) const {}
};

template <class Epi, class Sched, bool ALIGN_EPI = false, bool SP2 = false>
__device__ __forceinline__ void gemm_phase(LAS unsigned char* lds, const Gemm g, const Sched& S, const Epi& E, int wv) {
    const int tid = tid_opaque(wv), wid = __builtin_amdgcn_readfirstlane(tid >> 6), lane = tid & 63, wr = wid >> 2, wc = wid & 3, fr = lane & 15, fq = lane >> 4;
    const int K = g.ld, nt = g.K / BK;
    unsigned voffA[2], voffB[2];
#pragma unroll
    for (int i = 0; i < 2; ++i) { int R, C; stage_rc(tid * 16 + i * 8192, R, C); const int Rb = Epi::PERM ? ((R & ~31) + perm32(R & 31)) : R;
        voffA[i] = (unsigned)(R * K + C) * 2u; voffB[i] = (unsigned)(Rb * K + C) * 2u; }
    const size_t kstep = (size_t)(BK * 2);
    const size_t hstep = (size_t)HALF * K * 2;
    const size_t tstep = 2 * hstep;
    const unsigned ldsw = (unsigned)wid * 1024u;
    const int aoff = lds_byte(wr * 64 + fr, fq * 8), boff = lds_byte(wc * 32 + fr, fq * 8);
#define PG8_SA(b, h) (((b) * 2 + (h)) * HTB)
#define PG8_SB(b, h) ((4 + (b) * 2 + (h)) * HTB)
#define PG8_STAGE(bufoff, gbase, voff) do { _Pragma("unroll") for (int _i = 0; _i < 2; ++_i) \
        __builtin_amdgcn_global_load_lds((const unsigned*)((const char*)(gbase) + (voff)[_i]), (LAS unsigned*)(lds + (bufoff) + ldsw + _i * 8192), 16, 0, 0); } while (0)
#define PG8_LDA(dst, b, h) do { _Pragma("unroll") for (int m = 0; m < 4; ++m) _Pragma("unroll") for (int k = 0; k < 2; ++k) dst[m][k] = *(const LAS bf16x8*)(lds + PG8_SA(b, h) + aoff + m * 2048 + k * 1024); } while (0)
#define PG8_LDB(dst, b, h) do { _Pragma("unroll") for (int n = 0; n < 2; ++n) _Pragma("unroll") for (int k = 0; k < 2; ++k) dst[n][k] = *(const LAS bf16x8*)(lds + PG8_SB(b, h) + boff + n * 2048 + k * 1024); } while (0)
#define PG8_MMA(ai, bj, At, Bt) do { __builtin_amdgcn_s_setprio(1); _Pragma("unroll") for (int m = 0; m < 4; ++m) _Pragma("unroll") for (int n = 0; n < 2; ++n) _Pragma("unroll") for (int k = 0; k < 2; ++k) \
        acc[ai][bj][m][n] = __builtin_amdgcn_mfma_f32_16x16x32_bf16(Bt[n][k], At[m][k], acc[ai][bj][m][n], 0, 0, 0); __builtin_amdgcn_s_setprio(0); } while (0)
#define PG8_WAIT_V(n) asm volatile("s_waitcnt vmcnt(" #n ")" ::: "memory")
#define PG8_WAIT_L(n) asm volatile("s_waitcnt lgkmcnt(" #n ")" ::: "memory")
#define PG8_BAR __builtin_amdgcn_s_barrier()
#define PG8_SCHED __builtin_amdgcn_sched_barrier(0)
    Unit cur, nxt; int ui = 0;
    if (!S.next(0, cur)) return;
    f32x4 acc[2][2][4][2];
#pragma unroll
    for (int a = 0; a < 2; ++a)
#pragma unroll
        for (int b = 0; b < 2; ++b)
#pragma unroll
            for (int m = 0; m < 4; ++m)
#pragma unroll
                for (int n = 0; n < 2; ++n) acc[a][b][m][n] = (f32x4){0.f, 0.f, 0.f, 0.f};
    bf16x8 At[4][2], B0[2][2], B1[2][2];
    const char* cA = (const char*)g.A + (size_t)cur.pm * tstep; const char* cB = (const char*)g.Bt + (size_t)cur.pn * tstep;
    S.a_ready(cur);
    if constexpr (SP2) {
        PG8_STAGE(PG8_SB(0, 0), cB, voffB); PG8_STAGE(PG8_SB(0, 1), cB + hstep, voffB); PG8_STAGE(PG8_SA(0, 0), cA, voffA); PG8_STAGE(PG8_SA(0, 1), cA + hstep, voffA);
        if (wr == 1) PG8_BAR;
        PG8_WAIT_V(2); PG8_BAR;
        PG8_STAGE(PG8_SB(1, 0), cB + kstep, voffB); PG8_STAGE(PG8_SA(1, 0), cA + kstep, voffA); PG8_STAGE(PG8_SB(1, 1), cB + hstep + kstep, voffB);
        PG8_WAIT_V(6); PG8_BAR;
    } else {
        PG8_STAGE(PG8_SB(0, 0), cB, voffB); PG8_STAGE(PG8_SA(0, 0), cA, voffA); PG8_STAGE(PG8_SB(0, 1), cB + hstep, voffB); PG8_STAGE(PG8_SA(0, 1), cA + hstep, voffA);
        if (wr == 1) PG8_BAR;
        PG8_WAIT_V(4); PG8_BAR;
        PG8_STAGE(PG8_SB(1, 0), cB + kstep, voffB); PG8_STAGE(PG8_SA(1, 0), cA + kstep, voffA); PG8_STAGE(PG8_SB(1, 1), cB + hstep + kstep, voffB);
        PG8_WAIT_V(6); PG8_BAR;
    }
    for (;;) {
        const bool has_next = S.next(ui + 1, nxt);
        const char* nA = has_next ? (const char*)g.A + (size_t)nxt.pm * tstep : cA; const char* nB = has_next ? (const char*)g.Bt + (size_t)nxt.pn * tstep : cB;
        for (int t = 0; t < nt; t += 2) {
            const bool last = (t == nt - 2);
            const char* a1 = cA + (size_t)(t + 1) * kstep;
            const char* a2 = last ? nA : cA + (size_t)(t + 2) * kstep; const char* b2 = last ? nB : cB + (size_t)(t + 2) * kstep;
            const char* a3 = a2 + kstep; const char* b3 = b2 + kstep;
            if (last && has_next) S.a_ready(nxt);
            if constexpr (SP2) {
            PG8_LDB(B0, 0, 0); PG8_LDB(B1, 0, 1); PG8_SCHED; PG8_LDA(At, 0, 0); PG8_STAGE(PG8_SA(1, 1), a1 + hstep, voffA);
            PG8_WAIT_V(8); PG8_WAIT_L(0); PG8_BAR; PG8_MMA(0, 0, At, B0); PG8_MMA(0, 1, At, B1); PG8_BAR; PG8_SCHED;
            PG8_LDA(At, 0, 1); PG8_STAGE(PG8_SB(0, 0), b2, voffB); PG8_STAGE(PG8_SB(0, 1), b2 + hstep, voffB); PG8_STAGE(PG8_SA(0, 0), a2, voffA);
            PG8_WAIT_V(8); PG8_WAIT_L(0); PG8_BAR; PG8_MMA(1, 0, At, B0); PG8_MMA(1, 1, At, B1); PG8_BAR; PG8_SCHED;
            PG8_LDB(B0, 1, 0); PG8_LDB(B1, 1, 1); PG8_SCHED; PG8_LDA(At, 1, 0); PG8_STAGE(PG8_SA(0, 1), a2 + hstep, voffA);
            PG8_WAIT_V(8); PG8_WAIT_L(0); PG8_BAR; PG8_MMA(0, 0, At, B0); PG8_MMA(0, 1, At, B1); PG8_BAR; PG8_SCHED;
            PG8_LDA(At, 1, 1); PG8_STAGE(PG8_SB(1, 0), b3, voffB); PG8_STAGE(PG8_SB(1, 1), b3 + hstep, voffB); PG8_STAGE(PG8_SA(1, 0), a3, voffA);
            PG8_WAIT_V(8); PG8_WAIT_L(0); PG8_BAR; PG8_MMA(1, 0, At, B0); PG8_MMA(1, 1, At, B1); PG8_BAR; PG8_SCHED;
            } else {
            PG8_LDB(B0, 0, 0); PG8_SCHED; PG8_LDA(At, 0, 0); PG8_STAGE(PG8_SA(1, 1), a1 + hstep, voffA);
            PG8_WAIT_L(8); PG8_BAR; PG8_WAIT_L(0); PG8_MMA(0, 0, At, B0); PG8_BAR; PG8_SCHED;
            PG8_LDB(B1, 0, 1); PG8_STAGE(PG8_SB(0, 0), b2, voffB);
            PG8_BAR; PG8_WAIT_L(0); PG8_MMA(0, 1, At, B1); PG8_BAR;
            PG8_LDA(At, 0, 1); PG8_STAGE(PG8_SA(0, 0), a2, voffA);
            PG8_BAR; PG8_WAIT_L(0); PG8_MMA(1, 0, At, B0); PG8_BAR; PG8_SCHED;
            PG8_STAGE(PG8_SB(0, 1), b2 + hstep, voffB);
            PG8_WAIT_V(6); PG8_BAR; PG8_MMA(1, 1, At, B1); PG8_BAR;
            PG8_LDB(B0, 1, 0); PG8_SCHED; PG8_LDA(At, 1, 0); PG8_STAGE(PG8_SA(0, 1), a2 + hstep, voffA);
            PG8_WAIT_L(8); PG8_BAR; PG8_WAIT_L(0); PG8_MMA(0, 0, At, B0); PG8_BAR; PG8_SCHED;
            PG8_LDB(B1, 1, 1); PG8_STAGE(PG8_SB(1, 0), b3, voffB);
            PG8_BAR; PG8_WAIT_L(0); PG8_MMA(0, 1, At, B1); PG8_BAR;
            PG8_LDA(At, 1, 1); PG8_STAGE(PG8_SA(1, 0), a3, voffA);
            PG8_BAR; PG8_WAIT_L(0); PG8_MMA(1, 0, At, B0); PG8_BAR; PG8_SCHED;
            PG8_STAGE(PG8_SB(1, 1), b3 + hstep, voffB);
            PG8_WAIT_V(6); PG8_BAR; PG8_MMA(1, 1, At, B1); PG8_BAR;
            }
        }
        if constexpr (ALIGN_EPI) { if (wr == 0) PG8_BAR; }
        { int le = __builtin_amdgcn_mbcnt_hi(~0u, __builtin_amdgcn_mbcnt_lo(~0u, 0u)); asm volatile("" : "+v"(le));
          E(acc, cur, wr, wc, le & 15, le >> 4); } S.done(cur);
        if (!has_next) break;
#pragma unroll
        for (int a = 0; a < 2; ++a)
#pragma unroll
            for (int b = 0; b < 2; ++b)
#pragma unroll
                for (int m = 0; m < 4; ++m)
#pragma unroll
                    for (int n = 0; n < 2; ++n) acc[a][b][m][n] = (f32x4){0.f, 0.f, 0.f, 0.f};
        cur = nxt; cA = nA; cB = nB; ++ui;
        if constexpr (ALIGN_EPI) { if (wr == 1) PG8_BAR; }
    }
    PG8_WAIT_V(0);
    if constexpr (!ALIGN_EPI) { if (wr == 0) PG8_BAR; }
    PG8_BAR;
#undef PG8_SA
#undef PG8_SB
#undef PG8_STAGE
#undef PG8_LDA
#undef PG8_LDB
#undef PG8_MMA
#undef PG8_WAIT_V
#undef PG8_WAIT_L
#undef PG8_BAR
#undef PG8_SCHED
}
}

constexpr int NB = 4, SEQ = 4096, DM = 1024, FF = 2816, MTOK = NB * SEQ;
constexpr float EPS = 1e-6f;
constexpr size_t MiB = 1u << 20;
constexpr size_t WS_SSQ = 0;
constexpr size_t WS_SSQQ = 512 * 1024;
constexpr size_t WS_SSQKV = 576 * 1024;
constexpr size_t WS_CNT = 640 * 1024;
constexpr size_t WS_BAR = 768 * 1024;
constexpr size_t WS_HID3 = 1 * MiB;
constexpr size_t WS_KR = 3 * MiB;
constexpr size_t WS_Z1 = 4 * MiB;
constexpr size_t WS_WGU = 20 * MiB;
constexpr size_t WS_WD = 64 * MiB;
constexpr size_t WS_WIN = 86 * MiB;
constexpr size_t WS_WPOOL = 90 * MiB;
constexpr size_t WS_WOUT = 91 * MiB;
constexpr size_t WS_WD1 = 93 * MiB;
constexpr size_t WS_WUP = 94 * MiB;
constexpr size_t WS_WO = 97 * MiB;
constexpr size_t WS_XB = 100 * MiB;
constexpr size_t WS_BIG = 132 * MiB;
constexpr size_t WS_ACT = WS_BIG;
constexpr size_t WS_APOOL = WS_BIG;
constexpr size_t WS_UC = WS_BIG + 16 * MiB;
constexpr size_t WS_PP = WS_BIG + 64 * MiB;
constexpr size_t WS_YC = WS_BIG + 80 * MiB;
constexpr size_t WS_Y = WS_BIG;
constexpr size_t WS_A2 = WS_BIG;
constexpr size_t WS_Q = WS_BIG + 12 * MiB;
constexpr size_t WS_KV = WS_BIG + 60 * MiB;
constexpr size_t WS_O = 20 * MiB;
constexpr size_t WS_END = 256 * MiB;
static_assert(WS_KV + (size_t)MTOK * 2048 * 2 <= WS_END && WS_YC + 16 * MiB <= WS_END && WS_ACT + (size_t)MTOK * FF * 2 <= WS_END, "ws map");
static_assert(WS_SSQKV == WS_SSQQ + (size_t)MTOK * 4, "ssq_kv follows ssq_q");
constexpr int LDS_BYTES = 147456;
constexpr int FFT_BUF = 8704 * 8;

using pg8::Unit;
typedef f32x4 AccT[2][2][4][2];
__device__ __forceinline__ float silu_mul(float g, float u) { return g * __builtin_amdgcn_rcpf(1.f + __expf(-g)) * u; }

struct EpiAct { static constexpr bool PERM = true;
    bf16_t* O; const float* ssq;
    __device__ __forceinline__ void operator()(const AccT& acc, const Unit& u, int wr, int wc, int fr, int fq) const {
        const int row0 = u.pm * 256 + wr * 64 + fr, col0 = u.pn * 128 + wc * 32 + 8 * fq;
        float rsv[8];
#pragma unroll
        for (int i = 0; i < 8; ++i) rsv[i] = ssq[row0 + (i >> 2) * 128 + (i & 3) * 16];
#pragma unroll
        for (int ai = 0; ai < 2; ++ai)
#pragma unroll
            for (int m = 0; m < 4; ++m) { const int row = row0 + ai * 128 + m * 16; const float rs = rsqrtf(rsv[ai * 4 + m] * (1.f / DM) + EPS);
                const float nrl = -1.4426950408889634f * rs, rs2 = rs * rs; f32x4 y[2];
#pragma unroll
                for (int n = 0; n < 2; ++n) { const f32x4 ag = acc[ai][0][m][n], au = acc[ai][1][m][n]; const f32x4 t = ag * nrl;
                    f32x4 d; d[0] = __builtin_amdgcn_exp2f(t[0]); d[1] = __builtin_amdgcn_exp2f(t[1]); d[2] = __builtin_amdgcn_exp2f(t[2]); d[3] = __builtin_amdgcn_exp2f(t[3]);
                    d = d + 1.0f; f32x4 r; r[0] = __builtin_amdgcn_rcpf(d[0]); r[1] = __builtin_amdgcn_rcpf(d[1]); r[2] = __builtin_amdgcn_rcpf(d[2]); r[3] = __builtin_amdgcn_rcpf(d[3]);
                    y[n] = ((ag * au) * rs2) * r; }
                u32x4 w; w.x = cvt_pk_bf16(y[0][0], y[0][1]); w.y = cvt_pk_bf16(y[0][2], y[0][3]); w.z = cvt_pk_bf16(y[1][0], y[1][1]); w.w = cvt_pk_bf16(y[1][2], y[1][3]);
                *(u32x4*)(O + (size_t)row * FF + col0) = w; }
    }
};
struct EpiRes { static constexpr bool PERM = true;
    const float* xin32; bf16_t* xb; float* ssq_next; float alpha;
    __device__ __forceinline__ void operator()(const AccT& acc, const Unit& u, int wr, int wc, int fr, int fq) const {
        const int row0 = u.pm * 256 + wr * 64 + fr, col0 = u.pn * 256 + wc * 32 + 8 * fq;
        u32x4 xr[8][2];
#pragma unroll
        for (int i = 0; i < 8; ++i)
#pragma unroll
            for (int bj = 0; bj < 2; ++bj) xr[i][bj] = *(const u32x4*)(xb + (size_t)(row0 + (i >> 2) * 128 + (i & 3) * 16) * DM + col0 + bj * 128);
#pragma unroll
        for (int ai = 0; ai < 2; ++ai)
#pragma unroll
            for (int m = 0; m < 4; ++m) { const int row = row0 + ai * 128 + m * 16; float sq = 0.f;
#pragma unroll
                for (int bj = 0; bj < 2; ++bj) { const size_t off = (size_t)row * DM + col0 + bj * 128; f32x4 x0, x1;
                    if (xin32) { x0 = *(const f32x4*)(xin32 + off); x1 = *(const f32x4*)(xin32 + off + 4); }
                    else { const u32x4 w = xr[ai * 4 + m][bj];
                        x0 = (f32x4){__builtin_bit_cast(float, w.x << 16), __builtin_bit_cast(float, w.x & 0xffff0000u), __builtin_bit_cast(float, w.y << 16), __builtin_bit_cast(float, w.y & 0xffff0000u)};
                        x1 = (f32x4){__builtin_bit_cast(float, w.z << 16), __builtin_bit_cast(float, w.z & 0xffff0000u), __builtin_bit_cast(float, w.w << 16), __builtin_bit_cast(float, w.w & 0xffff0000u)}; }
                    x0 = x0 + acc[ai][bj][m][0] * alpha; x1 = x1 + acc[ai][bj][m][1] * alpha;
                    sq += ((x0[0] * x0[0] + x0[1] * x0[1]) + (x0[2] * x0[2] + x0[3] * x0[3])) + ((x1[0] * x1[0] + x1[1] * x1[1]) + (x1[2] * x1[2] + x1[3] * x1[3]));
                    u32x4 o; o.x = cvt_pk_bf16(x0[0], x0[1]); o.y = cvt_pk_bf16(x0[2], x0[3]); o.z = cvt_pk_bf16(x1[0], x1[1]); o.w = cvt_pk_bf16(x1[2], x1[3]);
                    *(u32x4*)(xb + off) = o; }
                sq += __shfl_xor(sq, 16); sq += __shfl_xor(sq, 32);
                if (fq == 0) atomicAdd(ssq_next + row, sq); }
    }
};
struct EpiResFinal { static constexpr bool PERM = true;
    const bf16_t* xb; float* ssq; unsigned* cnt; const float* gfin; float* out; float alpha; int wv;
    __device__ __forceinline__ void operator()(AccT& acc, const Unit& u, int wr, int wc, int fr, int fq) const {
        const int row0 = u.pm * 256 + wr * 64 + fr, col0 = u.pn * 256 + wc * 32 + 8 * fq;
        u32x4 xr[8][2];
#pragma unroll
        for (int i = 0; i < 8; ++i)
#pragma unroll
            for (int bj = 0; bj < 2; ++bj) xr[i][bj] = *(const u32x4*)(xb + (size_t)(row0 + (i >> 2) * 128 + (i & 3) * 16) * DM + col0 + bj * 128);
#pragma unroll
        for (int ai = 0; ai < 2; ++ai)
#pragma unroll
            for (int m = 0; m < 4; ++m) { const int row = row0 + ai * 128 + m * 16; float sq = 0.f;
#pragma unroll
                for (int bj = 0; bj < 2; ++bj) { const u32x4 w = xr[ai * 4 + m][bj];
                    f32x4 x0 = (f32x4){__builtin_bit_cast(float, w.x << 16), __builtin_bit_cast(float, w.x & 0xffff0000u), __builtin_bit_cast(float, w.y << 16), __builtin_bit_cast(float, w.y & 0xffff0000u)};
                    f32x4 x1 = (f32x4){__builtin_bit_cast(float, w.z << 16), __builtin_bit_cast(float, w.z & 0xffff0000u), __builtin_bit_cast(float, w.w << 16), __builtin_bit_cast(float, w.w & 0xffff0000u)};
                    x0 = x0 + acc[ai][bj][m][0] * alpha; x1 = x1 + acc[ai][bj][m][1] * alpha; acc[ai][bj][m][0] = x0; acc[ai][bj][m][1] = x1;
                    sq += ((x0[0] * x0[0] + x0[1] * x0[1]) + (x0[2] * x0[2] + x0[3] * x0[3])) + ((x1[0] * x1[0] + x1[1] * x1[1]) + (x1[2] * x1[2] + x1[3] * x1[3])); }
                sq += __shfl_xor(sq, 16); sq += __shfl_xor(sq, 32);
                if (fq == 0) atomicAdd(ssq + row, sq); }
        asm volatile("s_waitcnt vmcnt(0) lgkmcnt(0)" ::: "memory"); __builtin_amdgcn_s_barrier(); asm volatile("" ::: "memory");
        if (wv == 0) {
            if ((fr | fq) == 0) { __threadfence(); __hip_atomic_fetch_add(cnt + u.pm, 1u, __ATOMIC_RELAXED, __HIP_MEMORY_SCOPE_AGENT); }
            unsigned spins = 0;
            while (__hip_atomic_load(cnt + u.pm, __ATOMIC_RELAXED, __HIP_MEMORY_SCOPE_AGENT) < 4u && ++spins < (1u << 22)) __builtin_amdgcn_s_sleep(2);
        }
        asm volatile("s_waitcnt vmcnt(0) lgkmcnt(0)" ::: "memory"); __builtin_amdgcn_s_barrier(); asm volatile("" ::: "memory");
        float tot[8]; f32x4 gv[2][2];
        { const float* bp = ssq + row0;
          asm volatile("global_load_dword %0, %8, off sc1\n\tglobal_load_dword %1, %8, off offset:64 sc1\n\tglobal_load_dword %2, %8, off offset:128 sc1\n\tglobal_load_dword %3, %8, off offset:192 sc1\n\t"
                       "global_load_dword %4, %8, off offset:512 sc1\n\tglobal_load_dword %5, %8, off offset:576 sc1\n\tglobal_load_dword %6, %8, off offset:640 sc1\n\tglobal_load_dword %7, %8, off offset:704 sc1\n\t"
                       "s_waitcnt vmcnt(0)"
                       : "=&v"(tot[0]), "=&v"(tot[1]), "=&v"(tot[2]), "=&v"(tot[3]), "=&v"(tot[4]), "=&v"(tot[5]), "=&v"(tot[6]), "=&v"(tot[7]) : "v"(bp) : "memory"); }
#pragma unroll
        for (int bj = 0; bj < 2; ++bj) { gv[bj][0] = *(const f32x4*)(gfin + col0 + bj * 128); gv[bj][1] = *(const f32x4*)(gfin + col0 + bj * 128 + 4); }
#pragma unroll
        for (int ai = 0; ai < 2; ++ai)
#pragma unroll
            for (int m = 0; m < 4; ++m) { const int row = row0 + ai * 128 + m * 16; const float rs = rsqrtf(tot[ai * 4 + m] * (1.f / DM) + EPS);
#pragma unroll
                for (int bj = 0; bj < 2; ++bj) { const size_t off = (size_t)row * DM + col0 + bj * 128;
                    *(f32x4*)(out + off) = acc[ai][bj][m][0] * rs * gv[bj][0]; *(f32x4*)(out + off + 4) = acc[ai][bj][m][1] * rs * gv[bj][1]; } }
    }
};
struct EpiMixIn { static constexpr bool PERM = true;
    bf16_t* apool; bf16_t* uc; const float* ssq;
    __device__ __forceinline__ void operator()(const AccT& acc, const Unit& u, int wr, int wc, int fr, int fq) const {
        const int row0 = u.pm * 256 + wr * 64 + fr;
        float rsv[8];
#pragma unroll
        for (int i = 0; i < 8; ++i) rsv[i] = ssq[row0 + (i >> 2) * 128 + (i & 3) * 16];
#pragma unroll
        for (int ai = 0; ai < 2; ++ai)
#pragma unroll
            for (int m = 0; m < 4; ++m) { const int row = row0 + ai * 128 + m * 16; const float rs = rsqrtf(rsv[ai * 4 + m] * (1.f / DM) + EPS);
                if (u.pn < 2) {
#pragma unroll
                    for (int bj = 0; bj < 2; ++bj) { const f32x4 v0 = acc[ai][bj][m][0] * rs, v1 = acc[ai][bj][m][1] * rs;
                        u32x4 w; w.x = cvt_pk_bf16(v0[0], v0[1]); w.y = cvt_pk_bf16(v0[2], v0[3]); w.z = cvt_pk_bf16(v1[0], v1[1]); w.w = cvt_pk_bf16(v1[2], v1[3]);
                        *(u32x4*)(apool + (size_t)row * 512 + u.pn * 256 + bj * 128 + wc * 32 + 8 * fq) = w; }
                } else {
                    const int b = row >> 12, t = row & 4095;
#pragma unroll
                    for (int bj = 0; bj < 2; ++bj)
#pragma unroll
                        for (int n = 0; n < 2; ++n) { const f32x4 v = acc[ai][bj][m][n] * rs; const int ch = (u.pn - 2) * 256 + bj * 128 + wc * 32 + 8 * fq + 4 * n;
                            bf16_t* p = uc + (((size_t)(b * 1536 + ch)) << 12) + t;
                            p[0] = (bf16_t)f2bf(v[0]); p[4096] = (bf16_t)f2bf(v[1]); p[8192] = (bf16_t)f2bf(v[2]); p[12288] = (bf16_t)f2bf(v[3]); }
                } }
    }
};
struct EpiPlain { static constexpr bool PERM = true;
    bf16_t* O; int ldc;
    __device__ __forceinline__ void operator()(const AccT& acc, const Unit& u, int wr, int wc, int fr, int fq) const {
        const int row0 = u.pm * 256 + wr * 64 + fr, col0 = u.pn * 256 + wc * 32 + 8 * fq;
#pragma unroll
        for (int ai = 0; ai < 2; ++ai)
#pragma unroll
            for (int m = 0; m < 4; ++m) { const int row = row0 + ai * 128 + m * 16;
#pragma unroll
                for (int bj = 0; bj < 2; ++bj) { const f32x4 v0 = acc[ai][bj][m][0], v1 = acc[ai][bj][m][1];
                    u32x4 w; w.x = cvt_pk_bf16(v0[0], v0[1]); w.y = cvt_pk_bf16(v0[2], v0[3]); w.z = cvt_pk_bf16(v1[0], v1[1]); w.w = cvt_pk_bf16(v1[2], v1[3]);
                    *(u32x4*)(O + (size_t)row * ldc + col0 + bj * 128) = w; } }
    }
};
__device__ __forceinline__ void sincos_fast(float ang, float& s, float& c) {
    const float hi = 0.15915494f, lo = 6.4206383e-9f;
    const float r = ang * hi, e = fmaf(ang, hi, -r), k = rintf(r);
    const float frac = (r - k) + fmaf(ang, lo, e);
    s = __builtin_amdgcn_sinf(frac); c = __builtin_amdgcn_cosf(frac);
}
__device__ __forceinline__ float rope_inv_freq(int i) { return exp2f(-(float)(2 * i) * (13.287712379549449f / 32.f)); }
struct EpiM1 { static constexpr bool PERM = false;
    bf16_t* a2; bf16_t* kr; const float* ssq; float* ssq_q;
    __device__ __forceinline__ void operator()(const AccT& acc, const Unit& u, int wr, int wc, int fr, int fq) const {
        const int row0 = u.pm * 256 + wr * 64 + fr;
        float rsv[8];
#pragma unroll
        for (int i = 0; i < 8; ++i) rsv[i] = ssq[row0 + (i >> 2) * 128 + (i & 3) * 16];
#pragma unroll
        for (int ai = 0; ai < 2; ++ai)
#pragma unroll
            for (int m = 0; m < 4; ++m) { const int row = row0 + ai * 128 + m * 16; const float rs = rsqrtf(rsv[ai * 4 + m] * (1.f / DM) + EPS); float sq = 0.f;
                const int nbj = (u.pn == 0) ? 2 : 1;
#pragma unroll
                for (int bj = 0; bj < 2; ++bj) if (bj < nbj)
#pragma unroll
                    for (int n = 0; n < 2; ++n) { const f32x4 v = acc[ai][bj][m][n] * rs; sq += (v[0] * v[0] + v[1] * v[1]) + (v[2] * v[2] + v[3] * v[3]);
                        u32x2 w; w.x = cvt_pk_bf16(v[0], v[1]); w.y = cvt_pk_bf16(v[2], v[3]);
                        *(u32x2*)(a2 + (size_t)row * 384 + u.pn * 256 + bj * 128 + wc * 32 + n * 16 + 4 * fq) = w; }
                sq += __shfl_xor(sq, 16); sq += __shfl_xor(sq, 32);
                if (fq == 0) atomicAdd(ssq_q + (size_t)u.pn * MTOK + row, sq);
                if (u.pn == 1 && wc == 0) { const f32x4 x1 = acc[ai][1][m][0] * rs, x2 = acc[ai][1][m][1] * rs; const float pos = (float)(row & 4095);
                    float o1[4], o2[4];
#pragma unroll
                    for (int j = 0; j < 4; ++j) { const float ang = pos * rope_inv_freq(4 * fq + j); float c, s; sincos_fast(ang, s, c); o1[j] = x1[j] * c - x2[j] * s; o2[j] = x1[j] * s + x2[j] * c; }
                    u32x2 w1, w2; w1.x = cvt_pk_bf16(o1[0], o1[1]); w1.y = cvt_pk_bf16(o1[2], o1[3]); w2.x = cvt_pk_bf16(o2[0], o2[1]); w2.y = cvt_pk_bf16(o2[2], o2[3]);
                    *(u32x2*)(kr + (size_t)row * 32 + 4 * fq) = w1; *(u32x2*)(kr + (size_t)row * 32 + 16 + 4 * fq) = w2; }
                __builtin_amdgcn_sched_barrier(0); }
    }
};
struct EpiM2 { static constexpr bool PERM = false;
    bf16_t* q; bf16_t* kv; const float* ssq_q; const float* ssq_kv; int pn0;
    __device__ __forceinline__ void operator()(const AccT& acc, const Unit& u, int wr, int wc, int fr, int fq) const {
        asm volatile("" : "+v"(fr), "+v"(fq));
        const int upn = u.pn + pn0; const int row0 = u.pm * 256 + wr * 64 + fr; const bool isq = upn < 6;
        float rsv[8]; { const float* sp = isq ? ssq_q : ssq_q + MTOK;
#pragma unroll
          for (int i = 0; i < 8; ++i) rsv[i] = sp[row0 + (i >> 2) * 128 + (i & 3) * 16]; }
#pragma unroll
        for (int ai = 0; ai < 2; ++ai)
#pragma unroll
            for (int m = 0; m < 4; ++m) { const int row = row0 + ai * 128 + m * 16;
                const float rs = isq ? rsqrtf(rsv[ai * 4 + m] * (1.f / 256.f) + EPS) * 0.14724445f   : rsqrtf(rsv[ai * 4 + m] * (1.f / 128.f) + EPS);
                const float pos = (float)(row & 4095);
#pragma unroll
                for (int bj = 0; bj < 2; ++bj) { f32x4 v0 = acc[ai][bj][m][0] * rs, v1 = acc[ai][bj][m][1] * rs;
                    const int G = upn * 8 + bj * 4 + wc;
                    if (isq && (G % 3) == 2) {
#pragma unroll
                        for (int j = 0; j < 4; ++j) { const float ang = pos * rope_inv_freq(4 * fq + j); float c, s; sincos_fast(ang, s, c); const float a = v0[j], b = v1[j]; v0[j] = a * c - b * s; v1[j] = a * s + b * c; }
                    }
                    u32x2 w0, w1; w0.x = cvt_pk_bf16(v0[0], v0[1]); w0.y = cvt_pk_bf16(v0[2], v0[3]); w1.x = cvt_pk_bf16(v1[0], v1[1]); w1.y = cvt_pk_bf16(v1[2], v1[3]);
                    bf16_t* p = isq ? q + (size_t)row * 1536 + upn * 256 + bj * 128 + wc * 32 + 4 * fq : kv + (size_t)row * 2048 + (upn - 6) * 256 + bj * 128 + wc * 32 + 4 * fq;
                    *(u32x2*)p = w0; *(u32x2*)(p + 16) = w1; }
                __builtin_amdgcn_sched_barrier(0); }
    }
};

namespace att {
constexpr int NW = 8, QBLK = 32, KVBLK = 64;
constexpr float SCALE = 0.10206207261596575f;
constexpr float THR = 8.f;
constexpr int SHM_V = KVBLK * 64 * 2, SHM_K = KVBLK * 256;
#define KSWZ(row, colB) ((row) * 256 + ((colB) ^ (((row) & 7) << 4)))
#define SBAR() __builtin_amdgcn_sched_barrier(0)
__device__ __forceinline__ int crow(int r, int hi) { return (r & 3) + 8 * (r >> 2) + 4 * hi; }
constexpr float THR2 = THR * 1.4426950408889634f;
__device__ __forceinline__ void partialSM(f32x16& p0, f32x16& p1, float& m_ref, f32x16& negm, float& alpha, bool first) {
  float pmax = p0[0];
#pragma unroll
  for (int r = 1; r < 16; ++r) pmax = fmaxf(pmax, p0[r]);
#pragma unroll
  for (int r = 0; r < 16; ++r) pmax = fmaxf(pmax, p1[r]);
  { auto rr = __builtin_amdgcn_permlane32_swap(__float_as_uint(pmax), __float_as_uint(pmax), false, false);
    pmax = fmaxf(__uint_as_float(rr[0]), __uint_as_float(rr[1])); }
  if (__builtin_expect(!first && __all(pmax <= THR2), 1)) { alpha = 1.f; }
  else { const float dl = first ? pmax : fmaxf(pmax, 0.f); m_ref += dl; alpha = __builtin_amdgcn_exp2f(-dl);
#pragma unroll
    for (int r = 0; r < 16; ++r) { p0[r] -= dl; p1[r] -= dl; }
#pragma unroll
    for (int r = 0; r < 16; ++r) negm[r] = -m_ref; }
#pragma unroll
  for (int r = 0; r < 16; ++r) p0[r] = __builtin_amdgcn_exp2f(p0[r]);
}
__device__ __forceinline__ void finishSM(f32x16& p0, f32x16& p1, float alpha, float& l_reg, bf16x8& pa0, bf16x8& pa1, bf16x8& pa2, bf16x8& pa3) {
#pragma unroll
  for (int r = 0; r < 16; ++r) p1[r] = __builtin_amdgcn_exp2f(p1[r]);
  float ps = 0;
#pragma unroll
  for (int r = 0; r < 16; ++r) ps += p0[r];
#pragma unroll
  for (int r = 0; r < 16; ++r) ps += p1[r];
  { auto rr = __builtin_amdgcn_permlane32_swap(__float_as_uint(ps), __float_as_uint(ps), false, false);
    ps = __uint_as_float(rr[0]) + __uint_as_float(rr[1]); }
  l_reg = l_reg * alpha + ps;
#define PK4(P, BASE, OUT) do { u32x4 w = {cvt_pk_bf16(P[BASE + 0], P[BASE + 1]), cvt_pk_bf16(P[BASE + 2], P[BASE + 3]), \
    cvt_pk_bf16(P[BASE + 4], P[BASE + 5]), cvt_pk_bf16(P[BASE + 6], P[BASE + 7])}; OUT = *reinterpret_cast<bf16x8*>(&w); } while (0)
  PK4(p0, 0, pa0); PK4(p0, 8, pa1); PK4(p1, 0, pa2); PK4(p1, 8, pa3);
#undef PK4
}
__device__ __forceinline__ void qkt(f32x16& p0, f32x16& p1, const char* Ks, const bf16x8* qr, const f32x16& negm, int r32, int hi) {
  p0 = negm; p1 = negm;
#pragma unroll
  for (int d0 = 0; d0 < 6; ++d0) { int cb = (d0 * 16 + hi * 8) * 2;
    bf16x8 b0 = *reinterpret_cast<const bf16x8*>(Ks + KSWZ(r32, cb));
    bf16x8 b1 = *reinterpret_cast<const bf16x8*>(Ks + KSWZ(32 + r32, cb));
    p0 = __builtin_amdgcn_mfma_f32_32x32x16_bf16(b0, qr[d0], p0, 0, 0, 0);
    p1 = __builtin_amdgcn_mfma_f32_32x32x16_bf16(b1, qr[d0], p1, 0, 0, 0); }
}
__device__ __forceinline__ int v_st(int k, int c) { const int kk = k; return ((kk >> 3) * 2 + (c >> 5)) * 512 + ((kk & 7) * 32 + (c & 31)) * 2; }
__device__ __forceinline__ int v_rd_base(int lane) { return ((lane & 3) << 3) | (((lane >> 2) & 3) << 6) | (((lane >> 4) & 1) << 5) | (((lane >> 5) & 1) << 8); }
constexpr int v_rd_off(int d0, int ks, int half) { return d0 * 512 + ks * 2048 + half * 1024; }
template <int OFF> __device__ __forceinline__ s16x4 tr_read(int vb) {
  s16x4 r; asm volatile("ds_read_b64_tr_b16 %0, %1 offset:%2" : "=&v"(r) : "v"(vb), "i"(OFF) : "memory"); return r;
}
template <int D0> __device__ __forceinline__ void pv_one(f32x16& od, int vb, bf16x8 pa0, bf16x8 pa1, bf16x8 pa2, bf16x8 pa3) {
  const s16x4 l0 = tr_read<v_rd_off(D0, 0, 0)>(vb), h0 = tr_read<v_rd_off(D0, 0, 1)>(vb), l1 = tr_read<v_rd_off(D0, 1, 0)>(vb), h1 = tr_read<v_rd_off(D0, 1, 1)>(vb);
  const s16x4 l2 = tr_read<v_rd_off(D0, 2, 0)>(vb), h2 = tr_read<v_rd_off(D0, 2, 1)>(vb), l3 = tr_read<v_rd_off(D0, 3, 0)>(vb), h3 = tr_read<v_rd_off(D0, 3, 1)>(vb);
  asm volatile("s_waitcnt lgkmcnt(0)" ::: "memory"); SBAR();
#define PK(L, H) (bf16x8){L[0], L[1], L[2], L[3], H[0], H[1], H[2], H[3]}
  od = __builtin_amdgcn_mfma_f32_32x32x16_bf16(pa0, PK(l0, h0), od, 0, 0, 0);
  od = __builtin_amdgcn_mfma_f32_32x32x16_bf16(pa1, PK(l1, h1), od, 0, 0, 0);
  od = __builtin_amdgcn_mfma_f32_32x32x16_bf16(pa2, PK(l2, h2), od, 0, 0, 0);
  od = __builtin_amdgcn_mfma_f32_32x32x16_bf16(pa3, PK(l3, h3), od, 0, 0, 0);
#undef PK
}
__device__ __forceinline__ void pv_d0(f32x16* o, int vb, bf16x8 pa0, bf16x8 pa1, bf16x8 pa2, bf16x8 pa3) {
  pv_one<0>(o[0], vb, pa0, pa1, pa2, pa3); pv_one<1>(o[1], vb, pa0, pa1, pa2, pa3);
}
__device__ __forceinline__ void attn_unit(const bf16_t* __restrict__ Q, const bf16_t* __restrict__ KV, const bf16_t* __restrict__ KR, bf16_t* __restrict__ O, int b, int h, int qb, char* lds, int wv) {
  const int tid = tid_opaque(wv), wid = tid >> 6, lane = tid & 63, r32 = lane & 31, hi = lane >> 5;
  char* V_lds = lds; char* K_lds = lds + 2 * SHM_V;
  float* ws = (float*)(lds + 2 * SHM_V + 2 * SHM_K) + wid * 64; float* li_l = ws; float* al_l = ws + 32;
  float m_reg = 0.f, l_reg = 0; f32x16 o[2] = {}; bf16x8 qr[6]; f32x16 negm = {};
  const size_t rowbase = (size_t)b * SEQ;
  const bf16_t* Qw = Q + (rowbase + (size_t)qb * 256 + wid * QBLK + r32) * 1536 + h * 96 + hi * 8;
#pragma unroll
  for (int d0 = 0; d0 < 6; ++d0) qr[d0] = *reinterpret_cast<const bf16x8*>(Qw + d0 * 16);
  const int vr = tid >> 3, vc = (tid & 7) * 8, vst = v_st(vr, vc);
  const bf16_t* vsrc = KV + (rowbase + vr) * 2048 + h * 128 + 64 + vc;
  const int kc0 = tid & 15, kc = kc0 < 12 ? kc0 : kc0 - 4, sr = tid >> 4;
  const bf16_t* ksrc; size_t kstride;
  if (kc < 8) { ksrc = KV + (rowbase + sr) * 2048 + h * 128 + kc * 8; kstride = 2048; } else { ksrc = KR + (rowbase + sr) * 32 + (kc - 8) * 8; kstride = 32; }
  const int kst0 = KSWZ(sr, kc * 16), kst1 = KSWZ(32 + sr, kc * 16);
  const int vb0 = (int)(uintptr_t)V_lds + v_rd_base(lane);
  struct { bf16x8 vs, ks0, ks1; } sr_[2];
#define SLOAD(i, k0) do { sr_[i].vs = *reinterpret_cast<const bf16x8*>(vsrc + (size_t)(k0) * 2048); \
    sr_[i].ks0 = *reinterpret_cast<const bf16x8*>(ksrc + (size_t)(k0) * kstride); sr_[i].ks1 = *reinterpret_cast<const bf16x8*>(ksrc + (size_t)((k0) + 32) * kstride); } while (0)
#define SWRITE(bb, i) do { *(bf16x8*)(V_lds + (bb) * SHM_V + vst) = sr_[i].vs; \
    *(bf16x8*)(K_lds + (bb) * SHM_K + kst0) = sr_[i].ks0; *(bf16x8*)(K_lds + (bb) * SHM_K + kst1) = sr_[i].ks1; } while (0)
#define SWAIT() asm volatile("s_waitcnt vmcnt(3)" ::: "memory")
#define RESC(a) do { if (__any((a) < 1.f)) { if (hi == 0) al_l[r32] = (a); asm volatile("s_waitcnt lgkmcnt(0)" ::: "memory"); \
    _Pragma("unroll") for (int d = 0; d < 2; ++d) _Pragma("unroll") for (int r = 0; r < 16; ++r) o[d][r] *= al_l[crow(r, hi)]; } } while (0)
  f32x16 pA0, pA1, pB0, pB1; float alA, alB; bf16x8 pa0, pa1, pa2, pa3; const int NT = SEQ / KVBLK;
  constexpr int SE = 0, SO = 1;
  SLOAD(SE, 0); SLOAD(SO, KVBLK);
  SWAIT(); SWRITE(0, SE); __syncthreads();
  qkt(pA0, pA1, K_lds, qr, negm, r32, hi); partialSM(pA0, pA1, m_reg, negm, alA, true);
  SLOAD(SE, 2 * KVBLK);
  SWAIT(); SWRITE(1, SO); __syncthreads();
  for (int j = 1; j + 1 < NT; j += 2) {
    SBAR(); qkt(pB0, pB1, K_lds + SHM_K, qr, negm, r32, hi);
    finishSM(pA0, pA1, alA, l_reg, pa0, pa1, pa2, pa3); SBAR();
    SLOAD(SO, (j + 2) * KVBLK); SBAR();
    pv_d0(o, vb0, pa0, pa1, pa2, pa3); partialSM(pB0, pB1, m_reg, negm, alB, false);
    __syncthreads(); SWAIT(); SWRITE(0, SE);
    RESC(alB); __syncthreads();
    SBAR(); qkt(pA0, pA1, K_lds, qr, negm, r32, hi);
    finishSM(pB0, pB1, alB, l_reg, pa0, pa1, pa2, pa3); SBAR();
    if (j + 3 < NT) SLOAD(SE, (j + 3) * KVBLK); SBAR();
    pv_d0(o, vb0 + SHM_V, pa0, pa1, pa2, pa3); partialSM(pA0, pA1, m_reg, negm, alA, false);
    __syncthreads(); SWAIT(); SWRITE(1, SO);
    RESC(alA); __syncthreads();
  }
  SBAR(); qkt(pB0, pB1, K_lds + SHM_K, qr, negm, r32, hi);
  finishSM(pA0, pA1, alA, l_reg, pa0, pa1, pa2, pa3); SBAR();
  pv_d0(o, vb0, pa0, pa1, pa2, pa3); partialSM(pB0, pB1, m_reg, negm, alB, false);
  __syncthreads(); RESC(alB);
  finishSM(pB0, pB1, alB, l_reg, pa0, pa1, pa2, pa3); SBAR();
  pv_d0(o, vb0 + SHM_V, pa0, pa1, pa2, pa3);
  if (hi == 0) li_l[r32] = l_reg; asm volatile("s_waitcnt lgkmcnt(0)" ::: "memory");
  float rli[16];
#pragma unroll
  for (int r = 0; r < 16; ++r) rli[r] = __builtin_amdgcn_rcpf(li_l[crow(r, hi)]);
  bf16_t* Ow = O + (rowbase + (size_t)qb * 256 + wid * QBLK) * 1024 + h * 64;
#pragma unroll
  for (int r = 0; r < 16; ++r) { int orow = crow(r, hi);
#pragma unroll
    for (int d0 = 0; d0 < 2; ++d0) Ow[(size_t)orow * 1024 + d0 * 32 + r32] = (bf16_t)f2bf(o[d0][r] * rli[r]); }
  __syncthreads();
#undef SLOAD
#undef SWRITE
#undef SWAIT
#undef RESC
}
#undef SBAR
}

struct Args { const float* in[29]; float* out; unsigned char* ws; int ph_lo, ph_hi; };
typedef const __attribute__((address_space(4))) Args CArgs;
__device__ __forceinline__ CArgs* opaque_args() { auto p = __builtin_amdgcn_kernarg_segment_ptr(); asm volatile("" : "+s"(p)); return (CArgs*)p; }
enum { I_X = 0, I_NORMG, I_WG, I_WU, I_WDN, I_WIN, I_POOLW, I_POOLS, I_CONVW, I_CONVB, I_HW1, I_HB1, I_HW2, I_HB2, I_HW3, I_HB3, I_SINF, I_HWOUT, I_DECAY, I_HBIAS,
       I_WOUT, I_WDQ, I_QNG, I_WUQ, I_WDKV, I_KVNG, I_WUKV, I_WO, I_FNG };

__device__ __forceinline__ void p0_transpose_item(const float* W, int ldw, const float* gk, bf16_t* WT, int ldk, int koff, int rmode, int roff, LAS float* scr, int kb, int nb, int lane) {
    const int k0 = 64 * kb, n0 = 32 * nb;
    { const int ksub = lane >> 3, nq = lane & 7; f32x4 v[8]; float gg[8];
#pragma unroll
      for (int i = 0; i < 8; ++i) { const int kk = 8 * i + ksub; v[i] = *(const f32x4*)(W + (size_t)(k0 + kk) * ldw + n0 + 4 * nq); gg[i] = gk ? gk[k0 + kk] : 1.f; }
#pragma unroll
      for (int i = 0; i < 8; ++i) { const int kk = 8 * i + ksub; LAS float* d = scr + kk * 33 + 4 * nq; d[0] = v[i][0] * gg[i]; d[1] = v[i][1] * gg[i]; d[2] = v[i][2] * gg[i]; d[3] = v[i][3] * gg[i]; } }
    asm volatile("s_waitcnt lgkmcnt(0)" ::: "memory");
    const int c = lane & 7;
#pragma unroll
    for (int j = 0; j < 4; ++j) { const int n = (lane >> 3) + 8 * j; const LAS float* s = scr + (8 * c) * 33 + n;
        u32x4 o; o.x = cvt_pk_bf16(s[0 * 33], s[1 * 33]); o.y = cvt_pk_bf16(s[2 * 33], s[3 * 33]); o.z = cvt_pk_bf16(s[4 * 33], s[5 * 33]); o.w = cvt_pk_bf16(s[6 * 33], s[7 * 33]);
        const int ng = n0 + n; const int drow = rmode ? ((ng >> 7) * 256 + (ng & 127) + roff) : (ng + roff);
        *(u32x4*)(WT + (size_t)drow * ldk + koff + k0 + 8 * c) = o; }
    asm volatile("s_waitcnt lgkmcnt(0)" ::: "memory");
}

__device__ __forceinline__ void convert_jobs(CArgs& a, LAS unsigned char* lds, int sets, int gw, int NGW, int wv) {
    const int tid = tid_opaque(wv), lane = tid & 63, wave = tid >> 6;
    unsigned char* ws = a.ws;
    LAS float* scr = (LAS float*)(lds + wave * 16384);
    constexpr int IT_GU = 16 * 88, IT_DN = 44 * 32;
    constexpr int NITEMS = 4 * (2 * IT_GU + IT_DN) + 16 * 64 + 16 * 32 + 16 * 8 + 16 * 5 + 4 * 48 + 2 * 64 + 16 * 32;
    for (int it = gw; it < NITEMS; it += NGW) {
        int r = it; const float* W = nullptr; int ldw = 0, nblk = 1; const float* gk = nullptr; bf16_t* WT = nullptr; int ldk = 0, koff = 0, rmode = 0, roff = 0; bool found = false;
#define JOB(on_, ni_, W_, ldw_, gk_, WT_, ldk_, koff_, rmode_, roff_) if (!found && (on_)) { if (r < (ni_)) { W = (W_); ldw = (ldw_); nblk = (ldw_) / 32; gk = (gk_); WT = (WT_); ldk = (ldk_); koff = (koff_); rmode = (rmode_); roff = (roff_); found = true; } else r -= (ni_); }
#pragma unroll
        for (int f = 0; f < 4; ++f) { const float* g = a.in[I_NORMG] + ((f >> 1) * 3 + ((f & 1) ? 2 : 0)) * DM; const bool on = (sets >> f) & 1;
            JOB(on, IT_GU, a.in[I_WG] + (size_t)f * DM * FF, FF, g, (bf16_t*)(ws + WS_WGU) + (size_t)f * 5632 * DM, DM, 0, 1, 0)
            JOB(on, IT_GU, a.in[I_WU] + (size_t)f * DM * FF, FF, g, (bf16_t*)(ws + WS_WGU) + (size_t)f * 5632 * DM, DM, 0, 1, 128)
            JOB(on, IT_DN, a.in[I_WDN] + (size_t)f * DM * FF, DM, nullptr, (bf16_t*)(ws + WS_WD) + (size_t)f * DM * FF, FF, 0, 0, 0) }
        JOB(sets & 1, 16 * 64, a.in[I_WIN], 2048, a.in[I_NORMG] + 1 * DM, (bf16_t*)(ws + WS_WIN), DM, 0, 0, 0)
        JOB(sets & 1, 16 * 32, a.in[I_WOUT], DM, nullptr, (bf16_t*)(ws + WS_WOUT), DM, 0, 0, 0)
        JOB(sets & 4, 16 * 8, a.in[I_WDQ], 256, a.in[I_NORMG] + 4 * DM, (bf16_t*)(ws + WS_WD1), DM, 0, 0, 0)
        JOB(sets & 4, 16 * 5, a.in[I_WDKV], 160, a.in[I_NORMG] + 4 * DM, (bf16_t*)(ws + WS_WD1), DM, 0, 0, 256)
        JOB(sets & 4, 4 * 48, a.in[I_WUQ], 1536, a.in[I_QNG], (bf16_t*)(ws + WS_WUP), 384, 0, 0, 0)
        JOB(sets & 4, 2 * 64, a.in[I_WUKV], 2048, a.in[I_KVNG], (bf16_t*)(ws + WS_WUP), 384, 256, 0, 1536)
        JOB(sets & 4, 16 * 32, a.in[I_WO], DM, nullptr, (bf16_t*)(ws + WS_WO), DM, 0, 0, 0)
#undef JOB
        if (!found) break;
        p0_transpose_item(W, ldw, gk, WT, ldk, koff, rmode, roff, scr, r / nblk, r % nblk, lane);
    }
}
__device__ __forceinline__ void p0_prologue(CArgs& a, LAS unsigned char* lds, int G, int vcu, int wv) {
    const int tid = tid_opaque(wv), lane = tid & 63, wave = tid >> 6;
    unsigned char* ws = a.ws;
    const int gw = vcu * 8 + wave, NGW = G * 8;
    convert_jobs(a, lds, (G == 256) ? 1 : 15, gw, NGW, wv);
    const int gt = vcu * 512 + tid, GT = G * 512;
    { bf16_t* wd1 = (bf16_t*)(ws + WS_WD1) + 416 * DM; for (int i = gt; i < 96 * DM / 8; i += GT) ((u32x4*)wd1)[i] = (u32x4){0u, 0u, 0u, 0u};
      bf16_t* wup = (bf16_t*)(ws + WS_WUP);
      for (int i = gt; i < 1536 * 16; i += GT) { const int rr = i >> 4, c8 = i & 15; *(u32x4*)(wup + (size_t)rr * 384 + 256 + c8 * 8) = (u32x4){0u, 0u, 0u, 0u}; }
      for (int i = gt; i < 2048 * 32; i += GT) { const int rr = 1536 + (i >> 5), c8 = i & 31; *(u32x4*)(wup + (size_t)rr * 384 + c8 * 8) = (u32x4){0u, 0u, 0u, 0u}; } }
    { bf16_t* wp = (bf16_t*)(ws + WS_WPOOL); const float* pw = a.in[I_POOLW]; const float* ps = a.in[I_POOLS];
      for (int i = gt; i < 512 * 512; i += GT) { const int n = i >> 9, k = i & 511, g = n >> 7; float v = 0.f; if ((k >> 7) == g) v = pw[((size_t)g * 128 + (k & 127)) * 128 + (n & 127)] * ps[n]; wp[i] = (bf16_t)f2bf(v); } }
    { float* z = (float*)(ws + WS_SSQ) + MTOK; for (int i = gt; i < 7 * MTOK; i += GT) z[i] = 0.f;
      float* z2 = (float*)(ws + WS_SSQQ); for (int i = gt; i < 2 * MTOK; i += GT) z2[i] = 0.f;
      unsigned* pc = (unsigned*)(ws + WS_CNT); for (int i = gt; i < 64; i += GT) pc[i] = 0u; }
    { const float* x = a.in[I_X]; bf16_t* xb = (bf16_t*)(ws + WS_XB); float* ssq0 = (float*)(ws + WS_SSQ);
      for (int m0 = gw; m0 < MTOK; m0 += 4 * NGW) {
          f32x4 v[4][4];
#pragma unroll
          for (int r = 0; r < 4; ++r) { const int m = (m0 + r * NGW < MTOK) ? m0 + r * NGW : m0; const f32x4* xr = (const f32x4*)(x + (size_t)m * DM) + lane;
#pragma unroll
              for (int j = 0; j < 4; ++j) v[r][j] = xr[64 * j]; }
#pragma unroll
          for (int r = 0; r < 4; ++r) { const int m = m0 + r * NGW; if (m < MTOK) { float s = 0.f;
              unsigned long long* o8 = (unsigned long long*)(xb + (size_t)m * DM) + lane;
#pragma unroll
              for (int j = 0; j < 4; ++j) { const f32x4 q = v[r][j]; s += (q[0] * q[0] + q[1] * q[1]) + (q[2] * q[2] + q[3] * q[3]);
                  o8[64 * j] = (unsigned long long)cvt_pk_bf16(q[0], q[1]) | ((unsigned long long)cvt_pk_bf16(q[2], q[3]) << 32); }
              s = wave_sum(s); if (lane == 0) ssq0[m] = s; } } } }

    { float* hid3 = (float*)(ws + WS_HID3); const float* w1 = a.in[I_HW1]; const float* w2 = a.in[I_HW2]; const float* w3 = a.in[I_HW3]; const float* sf = a.in[I_SINF];
      const float b1 = a.in[I_HB1][lane], b2 = a.in[I_HB2][lane], b3 = a.in[I_HB3][lane], s1 = sf[lane], s2 = sf[64 + lane], s3 = sf[128 + lane];
      float w1r[33], w2r[64], w3r[64];
#pragma unroll
      for (int i = 0; i < 33; ++i) w1r[i] = w1[i * 64 + lane];
#pragma unroll
      for (int i = 0; i < 64; ++i) { w2r[i] = w2[i * 64 + lane]; w3r[i] = w3[i * 64 + lane]; }
      for (int t = gw; t < SEQ; t += NGW) {
          float z = 0.f;
          if (lane == 0) z = (float)t * (1.f / (float)(SEQ - 1));
          else if (lane < 33) { const int bnd = (lane - 1) & 15; const float wt = (6.283185307179586f * (float)t) / (float)SEQ; const float f = 1e-4f + (float)bnd * ((15.f - 1e-4f) / 15.f); const float ph = wt * f;
              z = (lane < 17) ? cosf(ph) : -sinf(ph); }
          float acc1 = b1;
#pragma unroll
          for (int i = 0; i < 33; ++i) acc1 += __builtin_bit_cast(float, __builtin_amdgcn_readlane(__builtin_bit_cast(int, z), i)) * w1r[i];
          const float h1 = sinf(s1 * acc1);
          float acc2 = b2;
#pragma unroll
          for (int i = 0; i < 64; ++i) acc2 += __builtin_bit_cast(float, __builtin_amdgcn_readlane(__builtin_bit_cast(int, h1), i)) * w2r[i];
          const float h2 = sinf(s2 * acc2);
          float acc3 = b3;
#pragma unroll
          for (int i = 0; i < 64; ++i) acc3 += __builtin_bit_cast(float, __builtin_amdgcn_readlane(__builtin_bit_cast(int, h2), i)) * w3r[i];
          hid3[(size_t)t * 64 + lane] = sinf(s3 * acc3);
      } }
}

template <int HW> __device__ __forceinline__ void pool_chunk(const bf16_t* a, bf16_t* out, int t0) {
    float v[64 + 2 * HW];
#pragma unroll
    for (int i = 0; i < 64 + 2 * HW; ++i) { const int s = t0 - HW + i; const int sc = s < 0 ? 0 : (s > SEQ - 1 ? SEQ - 1 : s); const float x = bf2f(a[(size_t)sc * 512]); v[i] = (s == sc) ? x : 0.f; }
    float S = 0.f;
#pragma unroll
    for (int i = 0; i < 2 * HW; ++i) S += v[i];
#pragma unroll
    for (int j = 0; j < 64; ++j) { const int t = t0 + j; const int lo = (t - HW) > 0 ? (t - HW) : 0, hi = (t + HW) < SEQ ? (t + HW) : SEQ;
        out[(size_t)t * 512] = (bf16_t)f2bf(S * __builtin_amdgcn_rcpf((float)(hi - lo)) - v[HW + j]);
        S += v[j + 2 * HW] - v[j]; }
}
__device__ __forceinline__ void pool_item(const bf16_t* apool, bf16_t* pp, int item, int wv) {
    const int c = tid_opaque(wv), g = wv >> 1;
    const int b = item >> 6, t0 = (item & 63) * 64;
    const bf16_t* a = apool + (size_t)b * SEQ * 512 + c; bf16_t* o = pp + (size_t)b * SEQ * 512 + c;
    if (g == 0) pool_chunk<1>(a, o, t0); else if (g == 1) pool_chunk<2>(a, o, t0); else if (g == 2) pool_chunk<4>(a, o, t0); else pool_chunk<8>(a, o, t0);
}

#define HD __device__ __forceinline__
#define LDSP LAS
#ifdef __HIPCC__
typedef float cf __attribute__((ext_vector_type(2)));
#else
#ifndef CF_HOST_DEFINED
#define CF_HOST_DEFINED
struct cf { float x, y; };
#endif
#endif
#ifdef __HIPCC__
HD cf cmul(cf a, cf b) { cf t, r;
    asm("v_pk_mul_f32 %0, %1, %2 op_sel_hi:[1,0]" : "=v"(t) : "v"(a), "v"(b));
    asm("v_pk_fma_f32 %0, %1, %2, %3 op_sel:[1,1,0] op_sel_hi:[0,1,1] neg_lo:[1,0,0]" : "=v"(r) : "v"(a), "v"(b), "v"(t));
    return r; }
HD cf cmulc(cf a, cf b) { cf t, r;
    asm("v_pk_mul_f32 %0, %1, %2 op_sel_hi:[1,0]" : "=v"(t) : "v"(a), "v"(b));
    asm("v_pk_fma_f32 %0, %1, %2, %3 op_sel:[1,1,0] op_sel_hi:[0,1,1] neg_hi:[1,0,0]" : "=v"(r) : "v"(a), "v"(b), "v"(t));
    return r; }
HD cf cmul_s(cf a, cf b) { cf t, r;
    asm("v_pk_mul_f32 %0, %1, %2 op_sel_hi:[1,0]" : "=v"(t) : "v"(a), "s"(b));
    asm("v_pk_fma_f32 %0, %1, %2, %3 op_sel:[1,1,0] op_sel_hi:[0,1,1] neg_lo:[1,0,0]" : "=v"(r) : "v"(a), "s"(b), "v"(t));
    return r; }
HD cf cmulc_s(cf a, cf b) { cf t, r;
    asm("v_pk_mul_f32 %0, %1, %2 op_sel_hi:[1,0]" : "=v"(t) : "v"(a), "s"(b));
    asm("v_pk_fma_f32 %0, %1, %2, %3 op_sel:[1,1,0] op_sel_hi:[0,1,1] neg_hi:[1,0,0]" : "=v"(r) : "v"(a), "s"(b), "v"(t));
    return r; }
#else
HD cf cmul_s(cf a, cf b) { cf r; r.x = a.x * b.x - a.y * b.y; r.y = a.x * b.y + a.y * b.x; return r; }
HD cf cmulc_s(cf a, cf b) { cf r; r.x = a.x * b.x + a.y * b.y; r.y = a.y * b.x - a.x * b.y; return r; }
HD cf cmul(cf a, cf b) { cf r; r.x = a.x * b.x - a.y * b.y; r.y = a.x * b.y + a.y * b.x; return r; }
HD cf cmulc(cf a, cf b) { cf r; r.x = a.x * b.x + a.y * b.y; r.y = a.y * b.x - a.x * b.y; return r; }
#endif
HD cf cadd(cf a, cf b) { cf r; r.x = a.x + b.x; r.y = a.y + b.y; return r; }
HD cf csub(cf a, cf b) { cf r; r.x = a.x - b.x; r.y = a.y - b.y; return r; }
HD int PADI(int i) { return i + (i >> 4); }
template <int X> HD cf c16() {
    constexpr float C[8] = {1.f, 0.92387953251128674f, 0.70710678118654752f, 0.38268343236508977f, 0.f, -0.38268343236508977f, -0.70710678118654752f, -0.92387953251128674f};
    constexpr float S[8] = {0.f, -0.38268343236508977f, -0.70710678118654752f, -0.92387953251128674f, -1.f, -0.92387953251128674f, -0.70710678118654752f, -0.38268343236508977f};
    cf r; r.x = C[X]; r.y = S[X]; return r;
}
template <int X, bool CONJ> HD cf mulc16(cf v) {
    constexpr float R = 0.70710678118654752f; cf r;
    if constexpr (X == 0) { r = v; }
    else if constexpr (X == 4) {
#ifdef __HIPCC__
        cf c; c.x = CONJ ? -1.f : 1.f; c.y = CONJ ? 1.f : -1.f;
        asm("v_pk_mul_f32 %0, %1, %2 op_sel:[1,0] op_sel_hi:[0,1]" : "=v"(r) : "v"(v), "s"(c));
#else
        if (!CONJ) { r.x = v.y; r.y = -v.x; } else { r.x = -v.y; r.y = v.x; }
#endif
    }
    else { const cf c = c16<X>(); r = CONJ ? cmulc_s(v, c) : cmul_s(v, c); }
    return r;
}
template <int J, int Q, int I, bool INV> HD void bfly(cf (&v)[16]) {
    constexpr int hk = 8 >> J; constexpr int X = I * (8 / hk);
    const cf a = v[Q + I], b = v[Q + I + hk];
    if (!INV) { v[Q + I] = cadd(a, b); v[Q + I + hk] = mulc16<X, false>(csub(a, b)); }
    else { const cf bb = mulc16<X, true>(b); v[Q + I] = cadd(a, bb); v[Q + I + hk] = csub(a, bb); }
}
template <int J, bool INV> HD void stage16(cf (&v)[16]) {
    if constexpr (J == 0) { bfly<0,0,0,INV>(v); bfly<0,0,1,INV>(v); bfly<0,0,2,INV>(v); bfly<0,0,3,INV>(v); bfly<0,0,4,INV>(v); bfly<0,0,5,INV>(v); bfly<0,0,6,INV>(v); bfly<0,0,7,INV>(v); }
    if constexpr (J == 1) { bfly<1,0,0,INV>(v); bfly<1,0,1,INV>(v); bfly<1,0,2,INV>(v); bfly<1,0,3,INV>(v); bfly<1,8,0,INV>(v); bfly<1,8,1,INV>(v); bfly<1,8,2,INV>(v); bfly<1,8,3,INV>(v); }
    if constexpr (J == 2) { bfly<2,0,0,INV>(v); bfly<2,0,1,INV>(v); bfly<2,4,0,INV>(v); bfly<2,4,1,INV>(v); bfly<2,8,0,INV>(v); bfly<2,8,1,INV>(v); bfly<2,12,0,INV>(v); bfly<2,12,1,INV>(v); }
    if constexpr (J == 3) { bfly<3,0,0,INV>(v); bfly<3,2,0,INV>(v); bfly<3,4,0,INV>(v); bfly<3,6,0,INV>(v); bfly<3,8,0,INV>(v); bfly<3,10,0,INV>(v); bfly<3,12,0,INV>(v); bfly<3,14,0,INV>(v); }
}
constexpr int bitrev4(int k) { return ((k & 1) << 3) | ((k & 2) << 1) | ((k & 4) >> 1) | ((k & 8) >> 3); }
template <int M_LAST, bool INV> HD void fft_pass16(LDSP cf* buf, int g, cf W) {
    const int lo = g & (M_LAST - 1); const int base = (g / M_LAST) * (M_LAST * 16) + lo;
    cf v[16];
#pragma unroll
    for (int k = 0; k < 16; ++k) v[k] = buf[PADI(base + k * M_LAST)];
#ifdef __HIPCC__
    asm volatile("" : "+v"(W));
#endif
    if (!INV) { stage16<0, false>(v); stage16<1, false>(v); stage16<2, false>(v); stage16<3, false>(v);
        cf cur = W;
#pragma unroll
        for (int e = 1; e < 16; ++e) { v[bitrev4(e)] = cmul(v[bitrev4(e)], cur); if (e < 15) cur = cmul(cur, W); } }
    else {
        cf cur = W;
#pragma unroll
        for (int e = 1; e < 16; ++e) { v[bitrev4(e)] = cmulc(v[bitrev4(e)], cur); if (e < 15) cur = cmul(cur, W); }
        stage16<3, true>(v); stage16<2, true>(v); stage16<1, true>(v); stage16<0, true>(v); }
#pragma unroll
    for (int k = 0; k < 16; ++k) buf[PADI(base + k * M_LAST)] = v[k];
}
HD void fft_last_scale(LDSP cf* buf, int g, float sc) {
#pragma unroll
    for (int p = 0; p < 8; ++p) { const int i0 = PADI(16 * g + 2 * p), i1 = PADI(16 * g + 2 * p + 1); const cf a = buf[i0], b = buf[i1];
        cf s = cadd(a, b), d = csub(a, b); s.x *= sc; s.y *= sc; d.x *= sc; d.y *= sc; buf[i0] = s; buf[i1] = d; }
}
HD void fft_middle(LDSP cf* buf, const LDSP cf* H, int g) {
#pragma unroll
    for (int p = 0; p < 8; ++p) { const int i0 = PADI(16 * g + 2 * p), i1 = PADI(16 * g + 2 * p + 1); const cf a = buf[i0], b = buf[i1];
        const cf s = cmul(cadd(a, b), H[i0]), d = cmul(csub(a, b), H[i1]); buf[i0] = cadd(s, d); buf[i1] = csub(s, d); }
}
#undef HD
#undef LDSP
__device__ __forceinline__ cf tw_of(float frac) { cf r; r.x = __builtin_amdgcn_cosf(frac); r.y = -__builtin_amdgcn_sinf(frac); return r; }
__device__ __forceinline__ float xshfl(float v, int o, int l) { return __builtin_bit_cast(float, __builtin_amdgcn_ds_bpermute((l ^ o) << 2, __builtin_bit_cast(int, v))); }
__device__ __forceinline__ void fft_fwd3(LAS cf* buf, int tid, cf W0, cf W1, cf W2) {
    fft_pass16<512, false>(buf, tid, W0); __syncthreads(); fft_pass16<32, false>(buf, tid, W1); __syncthreads(); fft_pass16<2, false>(buf, tid, W2); __syncthreads();
}
__device__ __forceinline__ void fft_inv3(LAS cf* buf, int tid, cf W0, cf W1, cf W2) {
    fft_pass16<2, true>(buf, tid, W2); __syncthreads(); fft_pass16<32, true>(buf, tid, W1); __syncthreads(); fft_pass16<512, true>(buf, tid, W0); __syncthreads();
}
__device__ __forceinline__ float block_sum(float v, LAS float* red, int tid) {
    v = wave_sum(v); __syncthreads(); if ((tid & 63) == 0) red[tid >> 6] = v; __syncthreads();
    float s = 0.f;
#pragma unroll
    for (int i = 0; i < 8; ++i) s += red[i];
    return s;
}
__device__ __forceinline__ float sconv(const bf16_t* uc, int b, int ch, int t, float w0, float w1, float w2, float cb) {
    const bf16_t* u = uc + (((size_t)(b * 1536 + ch)) << 12) + t;
    const float xm = bf2f(u[t > 0 ? -1 : 0]), u0 = bf2f(u[0]), xp = bf2f(u[t < SEQ - 1 ? 1 : 0]);
    const float um = t > 0 ? xm : 0.f, up = t < SEQ - 1 ? xp : 0.f;
    return cb + w0 * um + w1 * u0 + w2 * up;
}
__device__ __forceinline__ void sconv8(const bf16_t* uc, int b, int ch, int tid, float w0, float w1, float w2, float cb, float (&out)[8]) {
    const bf16_t* u = uc + (((size_t)(b * 1536 + ch)) << 12) + 8 * tid;
    const u32x4 raw = *(const u32x4*)u;
    const float pv = bf2f(u[tid > 0 ? -1 : 0]), nx = bf2f(u[tid < 511 ? 8 : 7]);
    float x[10]; x[0] = tid > 0 ? pv : 0.f; x[9] = tid < 511 ? nx : 0.f;
#pragma unroll
    for (int i = 0; i < 4; ++i) { x[1 + 2 * i] = __builtin_bit_cast(float, raw[i] << 16); x[2 + 2 * i] = __builtin_bit_cast(float, raw[i] & 0xffff0000u); }
#pragma unroll
    for (int j = 0; j < 8; ++j) out[j] = cb + w0 * x[j] + w1 * x[j + 1] + w2 * x[j + 2];
}
__device__ __forceinline__ void hyena_block(CArgs& a, LAS unsigned char* lds, int blk, int wv) {
    const int tid = tid_opaque(wv);
    unsigned char* ws = a.ws;
    LAS cf* A = (LAS cf*)lds; LAS cf* Hb = (LAS cf*)(lds + FFT_BUF); LAS float* wl = (LAS float*)(lds + 2 * FFT_BUF); LAS float* red = wl + 512; LAS float* scl = red + 8;
    const float* hid3 = (const float*)(ws + WS_HID3); const bf16_t* uc = (const bf16_t*)(ws + WS_UC); bf16_t* yc = (bf16_t*)(ws + WS_YC);
    float* fs = a.out + (size_t)blk * 4 * 8192;
    cf* z1 = (cf*)(ws + WS_Z1) + (size_t)blk * 2 * 4096;
    const cf W0 = tw_of((float)tid * (1.f / 8192.f)), W1 = tw_of((float)(tid & 31) * (1.f / 512.f)), W2 = tw_of((float)(tid & 1) * (1.f / 32.f));
#ifndef PROBE_PHASE
#define PROBE_PHASE -1
#endif
    for (int rp = 0; rp < ((PROBE_PHASE == 41) ? 2 : 1); ++rp) {
    __syncthreads();
    { const int f = tid >> 6, j = tid & 63, ci = f >> 2, o = (f >> 1) & 1, dir = f & 1;
      wl[tid] = a.in[I_HWOUT][(size_t)j * 2048 + o * 1024 + dir * 512 + blk + ci * 256]; }
    __syncthreads();
    LAS float* F = (LAS float*)lds;
    float ssq_l = 0.f;
    { const int lane = tid & 63, wvv = tid >> 6, rsub = lane >> 4, q = lane & 15, fsel = q >> 1, fo = fsel >> 1, dir = fsel & 1;
      int lop = lane; asm volatile("" : "+v"(lop));
      f32x4 w[8];
#pragma unroll
      for (int f = 0; f < 8; ++f) w[f] = *(const LAS f32x4*)(wl + f * 64 + 4 * q);
      const float mydec = fabsf(a.in[I_DECAY][(((fsel >> 1) & 1) * 2 + dir) * 512 + blk + (fsel >> 2) * 256]);
      const float* hbase = hid3 + (size_t)(512 * wvv + rsub) * 64 + 4 * q;
#define SWEEP_LOAD(HB, IB) do { _Pragma("unroll") for (int ii = 0; ii < 16; ++ii) HB[ii] = *(const f32x4*)(hbase + (size_t)(16 * (IB) + ii) * 256); } while (0)
#define SWEEP_PROC(HB, IB) do { _Pragma("unroll") for (int ii = 0; ii < 16; ++ii) { const int it = 16 * (IB) + ii; const int row = 512 * wvv + 4 * it + rsub; const f32x4 h = HB[ii]; \
          float p[8]; \
          _Pragma("unroll") for (int f = 0; f < 8; ++f) p[f] = (h[0] * w[f][0] + h[1] * w[f][1]) + (h[2] * w[f][2] + h[3] * w[f][3]); \
          float p1[4], p2[2]; \
          _Pragma("unroll") for (int jj = 0; jj < 4; ++jj) { const float snd = (q & 8) ? p[jj] : p[jj + 4], kp = (q & 8) ? p[jj + 4] : p[jj]; p1[jj] = kp + xshfl(snd, 8, lop); } \
          _Pragma("unroll") for (int jj = 0; jj < 2; ++jj) { const float snd = (q & 4) ? p1[jj] : p1[jj + 2], kp = (q & 4) ? p1[jj + 2] : p1[jj]; p2[jj] = kp + xshfl(snd, 4, lop); } \
          float p3; { const float snd = (q & 2) ? p2[0] : p2[1], kp = (q & 2) ? p2[1] : p2[0]; p3 = kp + xshfl(snd, 2, lop); } \
          p3 += xshfl(p3, 1, lop); \
          if ((q & 1) == 0) { const float tt = (float)row * (1.f / (float)(SEQ - 1)); float val = p3 * __expf(-tt * mydec); \
              int idx = dir ? 8192 - row : row; if (dir && row == 0) { idx = 4096; val = 0.f; } \
              F[(fsel >> 1) * 8192 + idx] = val; ssq_l += val * val; } } } while (0)
      { f32x4 hbA[16], hbB[16];
        SWEEP_LOAD(hbA, 0);
#pragma unroll 1
        for (int ib = 0; ib < 8; ib += 2) { SWEEP_LOAD(hbB, ib + 1); SWEEP_PROC(hbA, ib); if (ib + 2 < 8) SWEEP_LOAD(hbA, ib + 2); SWEEP_PROC(hbB, ib + 1); } }
#undef SWEEP_LOAD
#undef SWEEP_PROC
#pragma unroll
      for (int k = 0; k < 4; ++k) { const float s = block_sum(((q & 1) == 0 && (fsel >> 1) == k) ? ssq_l : 0.f, red, tid); if (tid == 0) scl[k] = rsqrtf(s) * (1.f / 8192.f); }
    }
    __syncthreads();
#pragma unroll
    for (int fo = 0; fo < 4; ++fo) { float* dst = fs + (size_t)fo * 8192; const LAS float* src = F + fo * 8192;
#pragma unroll
        for (int i = 0; i < 8; ++i) { const int t = tid + 512 * i, tb = t >= 1 ? 8192 - t : 4096; const float va = src[t], vb = src[tb]; dst[t] = va; dst[tb] = vb; } }
    __syncthreads();
    }
    const float* cw = a.in[I_CONVW]; const float* cbv = a.in[I_CONVB];
    for (int ci = 0; ci < 2; ++ci) { const int c = blk + ci * 256;
        for (int o = 0; o < 2; ++o) {
            { const float* src = fs + (size_t)(ci * 2 + o) * 8192; float fa[8], fb[8];
#pragma unroll
              for (int i = 0; i < 8; ++i) { const int t = tid + 512 * i, tb = t >= 1 ? 8192 - t : 4096; fa[i] = src[t]; fb[i] = src[tb]; }
#pragma unroll
              for (int i = 0; i < 8; ++i) { const int t = tid + 512 * i, tb = t >= 1 ? 8192 - t : 4096; cf v; v.y = 0.f; v.x = fa[i]; Hb[PADI(t)] = v; v.x = fb[i]; Hb[PADI(tb)] = v; } }
            __syncthreads();
#if PROBE_PHASE == 42
            fft_fwd3(Hb, tid, W0, W1, W2); fft_inv3(Hb, tid, W0, W1, W2);
            fft_fwd3(Hb, tid, W0, W1, W2);
            fft_last_scale(Hb, tid, scl[ci * 2 + o] * (1.f / 4096.f));
#else
            fft_fwd3(Hb, tid, W0, W1, W2);
            fft_last_scale(Hb, tid, scl[ci * 2 + o]);
#endif
            __syncthreads();
            const int zch = 1024 + c, gch = o * 512 + c;
            const float zw0 = cw[zch], zw1 = cw[1536 + zch], zw2 = cw[3072 + zch], zcb = cbv[zch];
            const float gw0 = cw[gch], gw1 = cw[1536 + gch], gw2 = cw[3072 + gch], gcb = cbv[gch];
            const float bias = a.in[I_HBIAS][o * 512 + c];
            for (int bp = 0; bp < 2; ++bp) { const int b0 = 2 * bp, b1 = 2 * bp + 1;
                cf zz[8];
                { if (o == 0) { float za[8], zb[8]; sconv8(uc, b0, zch, tid, zw0, zw1, zw2, zcb, za); sconv8(uc, b1, zch, tid, zw0, zw1, zw2, zcb, zb);
#pragma unroll
                      for (int j = 0; j < 8; ++j) { zz[j].x = za[j]; zz[j].y = zb[j]; } }
                  else { const f32x4* zp = (const f32x4*)(z1 + bp * 4096 + 8 * tid);
#pragma unroll
                      for (int j = 0; j < 4; ++j) { const f32x4 q4 = zp[j]; zz[2 * j].x = q4[0]; zz[2 * j].y = q4[1]; zz[2 * j + 1].x = q4[2]; zz[2 * j + 1].y = q4[3]; } }
#pragma unroll
                  for (int j = 0; j < 8; ++j) { A[PADI(8 * tid + j)] = zz[j]; cf zero; zero.x = 0.f; zero.y = 0.f; A[PADI(4096 + 8 * tid + j)] = zero; } }
                float ga[8], gb[8]; sconv8(uc, b0, gch, tid, gw0, gw1, gw2, gcb, ga); sconv8(uc, b1, gch, tid, gw0, gw1, gw2, gcb, gb);
                __syncthreads();
                fft_fwd3(A, tid, W0, W1, W2);
                fft_middle(A, Hb, tid); __syncthreads();
                fft_inv3(A, tid, W0, W1, W2);
                {
                  float r0[8], r1[8];
#pragma unroll
                  for (int j = 0; j < 8; ++j) { const cf y = A[PADI(8 * tid + j)]; r0[j] = ga[j] * (y.x + zz[j].x * bias); r1[j] = gb[j] * (y.y + zz[j].y * bias); }
                  if (o == 0) { f32x4* zp = (f32x4*)(z1 + bp * 4096 + 8 * tid);
#pragma unroll
                      for (int j = 0; j < 4; ++j) zp[j] = (f32x4){r0[2 * j], r1[2 * j], r0[2 * j + 1], r1[2 * j + 1]}; }
                  else { u32x4 w0v, w1v;
#pragma unroll
                      for (int j = 0; j < 4; ++j) { w0v[j] = cvt_pk_bf16(r0[2 * j], r0[2 * j + 1]); w1v[j] = cvt_pk_bf16(r1[2 * j], r1[2 * j + 1]); }
                      *(u32x4*)(yc + (((size_t)(b0 * 512 + c)) << 12) + 8 * tid) = w0v; *(u32x4*)(yc + (((size_t)(b1 * 512 + c)) << 12) + 8 * tid) = w1v; } }
                __syncthreads();
            }
        }
    }
}
__device__ __forceinline__ void transpose_tiles(const bf16_t* yc, bf16_t* y, LAS unsigned char* lds, int nblk, int iblk, int wv) {
    const int tid = tid_opaque(wv), lane = tid & 63, wave = tid >> 6;
    LAS bf16_t* s = (LAS bf16_t*)(lds + wave * 16384);
    for (int tile = iblk * 8 + wave; tile < 4 * 8 * 64; tile += nblk * 8) { const int b = tile >> 9, cb = (tile >> 6) & 7, tb = tile & 63;
        const bf16_t* src = yc + (((size_t)(b * 512 + cb * 64)) << 12) + tb * 64 + lane;
        bf16_t tv[64];
#pragma unroll
        for (int i = 0; i < 64; ++i) tv[i] = src[(size_t)i << 12];
#pragma unroll
        for (int i = 0; i < 64; ++i) s[i * 66 + lane] = tv[i];
        asm volatile("s_waitcnt lgkmcnt(0)" ::: "memory");
        bf16_t* dst = y + ((size_t)b * SEQ + tb * 64) * 1024 + 512 + cb * 64 + lane;
#pragma unroll 8
        for (int i = 0; i < 64; ++i) dst[(size_t)i * 1024] = s[lane * 66 + i];
        asm volatile("s_waitcnt lgkmcnt(0)" ::: "memory");
    }
}

#define XB_TMO      128
#define XB_XCNT(j)  (256  + 64 * (j))
#define XB_XSUB(j)  (1280 + 64 * (j))
#define XB_XGEN(j)  (2304 + 64 * (j))
#define XB_TOP      3328
#define XB_TOPGEN   3392
#define XCD_BAR_WORDS 3456
#define XB_SPIN_CAP (1u << 18)
__device__ __forceinline__ unsigned xb_ld(unsigned* p)              { return __hip_atomic_load(p, __ATOMIC_RELAXED, __HIP_MEMORY_SCOPE_AGENT); }
__device__ __forceinline__ unsigned xb_add(unsigned* p, unsigned v) { return __hip_atomic_fetch_add(p, v, __ATOMIC_RELAXED, __HIP_MEMORY_SCOPE_AGENT); }
__device__ __forceinline__ unsigned xb_xcc_id() { return (unsigned)__builtin_amdgcn_s_getreg((3 << 11) | 20) & 0xFu; }
#define XB_SPIN(cond, bar) do { unsigned _sp = 0; while (cond) { __builtin_amdgcn_s_sleep(1); \
    if ((++_sp & 255u) == 0u) { if (xb_ld(&(bar)[XB_TMO])) break; if (_sp > XB_SPIN_CAP) { atomicAdd(&(bar)[XB_TMO], 1u); break; } } } } while (0)
struct XcdBarrier { unsigned* bar; unsigned x; volatile LAS unsigned* st; };
__device__ __forceinline__ XcdBarrier xcd_barrier_post(unsigned* bar, volatile LAS unsigned* st) {
    XcdBarrier b; b.bar = bar; b.x = xb_xcc_id(); b.st = st;
    if (threadIdx.x == 0) (void)xb_add(&bar[XB_XCNT(b.x)], 1u);
    return b;
}
__device__ __forceinline__ void xcd_barrier_complete(unsigned* bar, unsigned x, unsigned& nloc, unsigned& nx) {
    const unsigned G = gridDim.x * gridDim.y * gridDim.z;
    unsigned sum, cnt, mine, sp = 0u;
    for (;;) {
        sum = 0u; cnt = 0u; mine = 0u;
#pragma unroll
        for (unsigned j = 0; j < 16; ++j) { const unsigned c = xb_ld(&bar[XB_XCNT(j)]); sum += c; cnt += (c > 0u) ? 1u : 0u; mine = (j == x) ? c : mine; }
        if (sum == G) break;
        __builtin_amdgcn_s_sleep(1);
        if ((++sp & 255u) == 0u) { if (xb_ld(&bar[XB_TMO])) break; if (sp > XB_SPIN_CAP) { atomicAdd(&bar[XB_TMO], 1u); break; } }
    }
    nloc = mine > 0u ? mine : 1u; nx = cnt > 0u ? cnt : 1u;
}
__device__ __forceinline__ void xcd_barrier(unsigned* bar_, volatile LAS unsigned* st_, int wv) {
    XcdBarrier b; b.bar = bar_; b.st = st_; b.x = 0u;
    asm volatile("s_waitcnt vmcnt(0)" ::: "memory");
    __syncthreads();
    if (tid_opaque(wv) == 0) {
        unsigned* bar = b.bar; b.x = xb_xcc_id();
        __builtin_amdgcn_s_waitcnt(0);
        unsigned nloc = b.st[0], nx = b.st[1];
        if (nloc == 0u) { xcd_barrier_complete(bar, b.x, nloc, nx); b.st[0] = nloc; b.st[1] = nx; }
        const unsigned old = xb_add(&bar[XB_XSUB(b.x)], 1u);
        const unsigned gen = old / nloc;
        if (old + 1u == (gen + 1u) * nloc) {
            __builtin_amdgcn_fence(__ATOMIC_RELEASE, "agent");
            asm volatile("s_waitcnt vmcnt(0)" ::: "memory");
            const unsigned og = xb_add(&bar[XB_TOP], 1u);
            const unsigned tg = og / nx;
            if (og + 1u == (tg + 1u) * nx) xb_add(&bar[XB_TOPGEN], 1u);
            else XB_SPIN(xb_ld(&bar[XB_TOPGEN]) == tg, bar);
            __builtin_amdgcn_fence(__ATOMIC_ACQUIRE, "agent");
            xb_add(&bar[XB_XGEN(b.x)], 1u);
            asm volatile("s_waitcnt vmcnt(0)" ::: "memory");
        } else {
            XB_SPIN(xb_ld(&bar[XB_XGEN(b.x)]) == gen, bar);
            __builtin_amdgcn_fence(__ATOMIC_ACQUIRE, "agent");
            asm volatile("s_waitcnt vmcnt(0)" ::: "memory");
        }
    }
    __syncthreads();
}

constexpr int NPH = 18;
__global__ void __launch_bounds__(512, 2) mega_fwd(Args a) {
    extern __shared__ __attribute__((aligned(16))) unsigned char lds_raw[];
    cg::grid_group grid = cg::this_grid();
    LAS unsigned char* lds = (LAS unsigned char*)lds_raw;
    const int G = gridDim.x, bx = blockIdx.x;
    const int wv = __builtin_amdgcn_readfirstlane((int)(threadIdx.x >> 6));
    const int vcu = (G % 8 == 0) ? (bx % 8) * (G / 8) + bx / 8 : bx;
    unsigned char* ws = a.ws;
    float* ssq = (float*)(ws + WS_SSQ); float* ssq_q = (float*)(ws + WS_SSQQ); float* ssq_kv = (float*)(ws + WS_SSQKV);
    bf16_t* XB = (bf16_t*)(ws + WS_XB); bf16_t* ACT = (bf16_t*)(ws + WS_ACT);
    float* X = a.out;
    const int lo = a.ph_lo, hi = a.ph_hi;
    volatile LAS unsigned* bst = (volatile LAS unsigned*)(lds + LDS_BYTES - 16);
    if (threadIdx.x < 2) bst[threadIdx.x] = 0u;
    __syncthreads();
    (void)xcd_barrier_post((unsigned*)(ws + WS_BAR), bst);
    if (lo < 0) grid.sync();
#ifndef PH_MASK
#define PH_MASK 0x3ffff
#endif
#define IN(k) ((((PH_MASK) >> (k)) & 1) && lo <= (k) && (k) < hi)
#ifndef PROBE_PHASE
#define PROBE_PHASE -1
#endif
#ifndef PROBE_SYNC
#define PROBE_SYNC 0
#endif
#define NREP(k) (((k) == PROBE_PHASE) ? 2 : 1)
#define SEAM(k) do { if (IN(k) && IN((k) + 1)) { xcd_barrier((unsigned*)(ws + WS_BAR), bst, wv); if (PROBE_SYNC) xcd_barrier((unsigned*)(ws + WS_BAR), bst, wv); } } while (0)
#define FFN_UP(k, f, sidx) if (IN(k)) for (int rep = 0; rep < NREP(k); ++rep) { pg8::Gemm g{XB, (const bf16_t*)(ws + WS_WGU) + (size_t)(f) * 5632 * DM, MTOK, 5632, DM, DM}; pg8::StaticOrder S; S.init(MTOK, 5632, G, bx); \
        EpiAct E{ACT, ssq + (sidx) * MTOK}; pg8::gemm_phase<EpiAct, pg8::StaticOrder, true, true>(lds, g, S, E, wv); }
#define FFN_DN(k, f, xin_, sidx) if (IN(k)) { pg8::Gemm g{ACT, (const bf16_t*)(ws + WS_WD) + (size_t)(f) * DM * FF, MTOK, DM, FF, FF}; pg8::StaticOrder S; S.init(MTOK, DM, G, bx); \
        EpiRes E{(xin_), XB, ssq + (sidx) * MTOK, 0.5f}; pg8::gemm_phase<EpiRes, pg8::StaticOrder, true, true>(lds, g, S, E, wv); } SEAM(k);

    if (IN(0)) for (int rep = 0; rep < NREP(0); ++rep) p0_prologue(*opaque_args(), lds, G, vcu, wv);
    SEAM(0);
    FFN_UP(1, 0, 0)
#define DEFER_CONVERT(k, sets) if (IN(k) && G == 256 && bx >= 128) { convert_jobs(*opaque_args(), lds, (sets), (bx - 128) * 8 + wv, 128 * 8, wv); }
    DEFER_CONVERT(1, 2)
    SEAM(1);
    FFN_DN(2, 0, (const float*)nullptr, 1)
#if PROBE_PHASE == 100
    if (IN(2)) { xcd_barrier((unsigned*)(ws + WS_BAR), bst, wv); pg8::Gemm g{ACT, (const bf16_t*)(ws + WS_WD), MTOK, DM, FF, FF}; pg8::StaticOrder S; S.init(MTOK, DM, G, bx);
        EpiPlain E{(bf16_t*)(ws + WS_BIG + 88 * MiB), 1024}; pg8::gemm_phase<EpiPlain, pg8::StaticOrder, false, true>(lds, g, S, E, wv); }
#endif
    if (IN(3)) for (int rep = 0; rep < NREP(3); ++rep) { pg8::Gemm g{XB, (const bf16_t*)(ws + WS_WIN), MTOK, 2048, DM, DM}; pg8::StaticOrder S; S.init(MTOK, 2048, G, bx);
        EpiMixIn E{(bf16_t*)(ws + WS_APOOL), (bf16_t*)(ws + WS_UC), ssq + 1 * MTOK}; pg8::gemm_phase<EpiMixIn, pg8::StaticOrder, true, true>(lds, g, S, E, wv); }
    SEAM(3);
    if (IN(4)) for (int rep = 0; rep < NREP(4); ++rep) {
        for (int rp = 0; rp < ((PROBE_PHASE == 40) ? 2 : 1); ++rp)
        for (int it = bx; it < 256; it += G) pool_item((const bf16_t*)(ws + WS_APOOL), (bf16_t*)(ws + WS_PP), it, wv);
        for (int blk = bx; blk < 256; blk += G) { __syncthreads(); hyena_block(*opaque_args(), lds, blk, wv); }
    }
    SEAM(4);
    if (IN(5)) for (int rep = 0; rep < NREP(5); ++rep) {
        __syncthreads();
        if (G == 256) { if (bx >= 128) transpose_tiles((const bf16_t*)(ws + WS_YC), (bf16_t*)(ws + WS_Y), lds, 128, bx - 128, wv); }
        else transpose_tiles((const bf16_t*)(ws + WS_YC), (bf16_t*)(ws + WS_Y), lds, G, bx, wv);
        __syncthreads();
        pg8::Gemm g{(const bf16_t*)(ws + WS_PP), (const bf16_t*)(ws + WS_WPOOL), MTOK, 512, 512, 512}; pg8::StaticOrder S; S.init(MTOK, 512, G, bx);
        EpiPlain E{(bf16_t*)(ws + WS_Y), 1024}; pg8::gemm_phase<EpiPlain, pg8::StaticOrder, true, true>(lds, g, S, E, wv);
    }
    SEAM(5);
    if (IN(6)) { pg8::Gemm g{(const bf16_t*)(ws + WS_Y), (const bf16_t*)(ws + WS_WOUT), MTOK, DM, DM, DM}; pg8::StaticOrder S; S.init(MTOK, DM, G, bx);
        EpiRes E{nullptr, XB, ssq + 2 * MTOK, 1.0f}; pg8::gemm_phase<EpiRes, pg8::StaticOrder, true, true>(lds, g, S, E, wv); }
    SEAM(6);
    FFN_UP(7, 1, 2)
    DEFER_CONVERT(7, 4)
    SEAM(7);
    FFN_DN(8, 1, (const float*)nullptr, 3)
    FFN_UP(9, 2, 3)
    DEFER_CONVERT(9, 8)
    SEAM(9);
    FFN_DN(10, 2, (const float*)nullptr, 4)
    if (IN(11)) { pg8::Gemm g{XB, (const bf16_t*)(ws + WS_WD1), MTOK, 512, DM, DM}; pg8::StaticOrder S; S.init(MTOK, 512, G, bx);
        EpiM1 E{(bf16_t*)(ws + WS_A2), (bf16_t*)(ws + WS_KR), ssq + 4 * MTOK, ssq_q}; pg8::gemm_phase<EpiM1, pg8::StaticOrder, true, true>(lds, g, S, E, wv); }
    SEAM(11);
    if (IN(12)) for (int rep = 0; rep < NREP(12); ++rep) {
        { pg8::Gemm g{(const bf16_t*)(ws + WS_A2), (const bf16_t*)(ws + WS_WUP), MTOK, 1536, 256, 384}; pg8::StaticOrder S; S.init(MTOK, 1536, G, bx);
          EpiM2 E{(bf16_t*)(ws + WS_Q), (bf16_t*)(ws + WS_KV), ssq_q, ssq_kv, 0}; pg8::gemm_phase<EpiM2, pg8::StaticOrder, true, true>(lds, g, S, E, wv); }
        { pg8::Gemm g{(const bf16_t*)(ws + WS_A2) + 128, (const bf16_t*)(ws + WS_WUP) + (size_t)1536 * 384 + 128, MTOK, 2048, 256, 384}; pg8::StaticOrder S; S.init(MTOK, 2048, G, bx);
          EpiM2 E{(bf16_t*)(ws + WS_Q), (bf16_t*)(ws + WS_KV), ssq_q, ssq_kv, 6}; pg8::gemm_phase<EpiM2, pg8::StaticOrder, true, true>(lds, g, S, E, wv); } }
    SEAM(12);
    if (IN(13)) for (int rep = 0; rep < NREP(13); ++rep) {
        for (int u = vcu; u < NB * 16 * 16; u += G) { const int bh = u >> 4, qb = u & 15;
            att::attn_unit((const bf16_t*)(ws + WS_Q), (const bf16_t*)(ws + WS_KV), (const bf16_t*)(ws + WS_KR), (bf16_t*)(ws + WS_O), bh >> 4, bh & 15, qb, (char*)lds_raw, wv); }
    }
    SEAM(13);
    if (IN(14)) { pg8::Gemm g{(const bf16_t*)(ws + WS_O), (const bf16_t*)(ws + WS_WO), MTOK, DM, DM, DM}; pg8::StaticOrder S; S.init(MTOK, DM, G, bx);
        EpiRes E{nullptr, XB, ssq + 5 * MTOK, 1.0f}; pg8::gemm_phase<EpiRes, pg8::StaticOrder, true, true>(lds, g, S, E, wv); }
    SEAM(14);
    FFN_UP(15, 3, 5)
    SEAM(15);
    if (IN(16)) {
        if (G == 256) {
            pg8::Gemm g{ACT, (const bf16_t*)(ws + WS_WD) + (size_t)3 * DM * FF, MTOK, DM, FF, FF}; pg8::StaticOrder S; S.init(MTOK, DM, G, bx);
            EpiResFinal E{XB, ssq + 6 * MTOK, (unsigned*)(ws + WS_CNT), opaque_args()->in[I_FNG], X, 0.5f, wv}; pg8::gemm_phase<EpiResFinal, pg8::StaticOrder, true, true>(lds, g, S, E, wv);
        } else {
            pg8::Gemm g{ACT, (const bf16_t*)(ws + WS_WD) + (size_t)3 * DM * FF, MTOK, DM, FF, FF}; pg8::StaticOrder S; S.init(MTOK, DM, G, bx);
            EpiRes E{nullptr, XB, ssq + 6 * MTOK, 0.5f}; pg8::gemm_phase<EpiRes, pg8::StaticOrder, true, true>(lds, g, S, E, wv);
        }
    }
    if (G != 256) SEAM(16);
    if (IN(17) && G != 256) {
        const int lane = tid_opaque(wv) & 63, gw = vcu * 8 + wv; const float* gf = opaque_args()->in[I_FNG];
        for (int m = gw; m < MTOK; m += G * 8) { const float rs = rsqrtf(ssq[6 * MTOK + m] * (1.f / DM) + EPS);
            const u32x2* xr = (const u32x2*)(XB + (size_t)m * DM) + lane; f32x4* orow = (f32x4*)(X + (size_t)m * DM) + lane;
#pragma unroll
            for (int j = 0; j < 4; ++j) { const u32x2 w = xr[64 * j]; const f32x4 gv = ((const f32x4*)gf)[lane + 64 * j];
                const f32x4 xv = {__builtin_bit_cast(float, w.x << 16), __builtin_bit_cast(float, w.x & 0xffff0000u), __builtin_bit_cast(float, w.y << 16), __builtin_bit_cast(float, w.y & 0xffff0000u)};
                orow[64 * j] = xv * rs * gv; } }
    }
#undef IN
#undef SEAM
#undef FFN_UP
#undef FFN_DN
}

extern "C" void kernel_launch(void* const* d_in, const int* in_sizes, int n_in, void* d_out, int out_size, void* d_ws, size_t ws_size, hipStream_t stream) {
    static int grid = 0;
    if (grid == 0) {
        if (n_in != 29 || out_size != MTOK * DM || ws_size < WS_END) { fprintf(stderr, "kernel_launch: unexpected shapes n_in %d out %d ws %zu\n", n_in, out_size, ws_size); grid = -1; return; }
        int dev = 0, cus = 0, per_cu = 0;
        if (hipGetDevice(&dev) != hipSuccess || hipDeviceGetAttribute(&cus, hipDeviceAttributeMultiprocessorCount, dev) != hipSuccess) { grid = -1; return; }
        if (hipFuncSetAttribute((const void*)mega_fwd, hipFuncAttributeMaxDynamicSharedMemorySize, LDS_BYTES) != hipSuccess) { fprintf(stderr, "kernel_launch: hipFuncSetAttribute failed\n"); grid = -1; return; }
        if (hipOccupancyMaxActiveBlocksPerMultiprocessor(&per_cu, (const void*)mega_fwd, 512, LDS_BYTES) != hipSuccess || per_cu < 1) { fprintf(stderr, "kernel_launch: occupancy query says %d\n", per_cu); per_cu = 1; }
        (void)hipGetLastError();
        grid = cus;
    }
    if (grid < 0) return;
    if (hipMemsetAsync((char*)d_ws + WS_BAR, 0, 16384, stream) != hipSuccess) { fprintf(stderr, "kernel_launch: memset failed\n"); return; }
    Args a{};
    for (int i = 0; i < 29; ++i) a.in[i] = (const float*)d_in[i];
    a.out = (float*)d_out; a.ws = (unsigned char*)d_ws; a.ph_lo = 0; a.ph_hi = NPH;
    void* args[] = {&a};
    hipError_t e = hipLaunchCooperativeKernel((const void*)mega_fwd, dim3(grid), dim3(512), args, LDS_BYTES, stream);
    if (e != hipSuccess) fprintf(stderr, "kernel_launch: cooperative launch failed: %s (grid %d)\n", hipGetErrorString(e), grid);
}
```
